# Optimizing an MI355X kernel written in HIP

```python
import math
import jax, jax.numpy as jnp
from jax import lax
import numpy as np

D_MODEL = 1024
BATCH = 1
SEQ = 16384
DEPTH = 1

HEAD_DIM = 64
ATT_GROUPS = ((128, 1), (512, 4), (2048, 16))
HEADS_PER_GROUP = 4
N_ATT_HEADS = HEADS_PER_GROUP * len(ATT_GROUPS)
ATT_WIDTH = N_ATT_HEADS * HEAD_DIM
ATT_MERGED = HEADS_PER_GROUP * HEAD_DIM
BLK = 128
POOL_WINDOWS = (2, 4, 8, 16)
POOL_GROUP_WIDTH = 3 * D_MODEL // 16
POOL_WIDTH = POOL_GROUP_WIDTH * len(POOL_WINDOWS)
D_FF = 4 * D_MODEL
N_IN = 3 * ATT_WIDTH + POOL_WIDTH + 2 * D_MODEL
NORM_EPS = 1e-6
ALIBI_MAX_BIAS = 8.0

kernel_name = "hybrid_dilated_attn_pool_gated_block"


def _rmsnorm(x, g):
    xf = x.astype(jnp.float32)
    y = xf * lax.rsqrt(jnp.mean(xf * xf, axis=-1, keepdims=True) + NORM_EPS)
    return (y * g.astype(jnp.float32)).astype(x.dtype)


def _dilated_window_attention(q, k, v, dilation, n_steps, slopes):
    B, S, H, Dh = q.shape
    L = S // dilation
    nb = -(-L // BLK)
    Lp = nb * BLK
    Z = B * dilation

    def to_sub(t):
        t = t.reshape(B, L, dilation, H, Dh).transpose(0, 2, 1, 3, 4).reshape(Z, L, H, Dh)
        return jnp.pad(t, ((0, 0), (0, Lp - L), (0, 0), (0, 0)))

    def band(t):
        prev = jnp.pad(t, ((0, 0), (BLK, 0), (0, 0), (0, 0)))[:, :Lp]
        return jnp.concatenate([prev.reshape(Z, nb, BLK, H, Dh),
                                t.reshape(Z, nb, BLK, H, Dh)], axis=2)

    qb = to_sub(q).reshape(Z, nb, BLK, H, Dh).astype(jnp.float32)
    kb = band(to_sub(k)).astype(jnp.float32)
    vb = band(to_sub(v)).astype(jnp.float32)

    s = jnp.einsum('znqhd,znkhd->znhqk', qb, kb) * (Dh ** -0.5)
    steps = BLK + jnp.arange(BLK)[:, None] - jnp.arange(2 * BLK)[None, :]
    key_idx = (jnp.arange(nb)[:, None, None] * BLK
               + jnp.arange(2 * BLK)[None, None, :] - BLK)
    valid = (steps >= 0) & (steps <= n_steps) & (key_idx >= 0)
    bias = -(slopes[:, None, None] * (steps * dilation).astype(jnp.float32))
    s = jnp.where(valid[None, :, None], s + bias[None, None], -jnp.inf)
    lse = jax.nn.logsumexp(s, axis=-1)
    p = jnp.exp(s - lse[..., None])
    o = jnp.einsum('znhqk,znkhd->znqhd', p, vb).reshape(Z, Lp, H, Dh)[:, :L]
    lse = lse.transpose(0, 1, 3, 2).reshape(Z, Lp, H)[:, :L]
    o = o.reshape(B, dilation, L, H, Dh).transpose(0, 2, 1, 3, 4).reshape(B, S, H, Dh)
    lse = lse.reshape(B, dilation, L, H).transpose(0, 2, 1, 3).reshape(B, S, H)
    return o, lse


def _attention_branch(q, k, v):
    B, S, _ = q.shape
    q = q.reshape(B, S, N_ATT_HEADS, HEAD_DIM)
    k = k.reshape(B, S, N_ATT_HEADS, HEAD_DIM)
    v = v.reshape(B, S, N_ATT_HEADS, HEAD_DIM)
    slopes = 2.0 ** (-ALIBI_MAX_BIAS * (jnp.arange(N_ATT_HEADS, dtype=jnp.float32) + 1.0)
                     / N_ATT_HEADS)
    outs, lses = [], []
    for g, (window, dilation) in enumerate(ATT_GROUPS):
        hs = slice(g * HEADS_PER_GROUP, (g + 1) * HEADS_PER_GROUP)
        o, l = _dilated_window_attention(q[:, :, hs], k[:, :, hs], v[:, :, hs],
                                         dilation, window // dilation, slopes[hs])
        outs.append(o)
        lses.append(l)
    outs = jnp.stack(outs, axis=0)
    wts = jax.nn.softmax(jnp.stack(lses, axis=0), axis=0)
    merged = jnp.sum(wts[..., None] * outs, axis=0)
    return merged.reshape(B, S, ATT_MERGED)


def _pool_branch(pz, w_grp, scale):
    B, S, _ = pz.shape
    pf = pz.astype(jnp.float32).reshape(B, S, len(POOL_WINDOWS), POOL_GROUP_WIDTH)
    c0 = jnp.pad(jnp.cumsum(pf, axis=1), ((0, 0), (1, 0), (0, 0), (0, 0)))
    t = jnp.arange(S)
    pooled = []
    for g, w in enumerate(POOL_WINDOWS):
        lower = jnp.take(c0[:, :, g], jnp.maximum(t + 1 - w, 0), axis=1)
        count = jnp.minimum(t + 1, w).astype(jnp.float32)[None, :, None]
        pooled.append((c0[:, 1:, g] - lower) / count)
    pooled = jnp.stack(pooled, axis=2) - pf
    mixed = jnp.einsum('bsgc,gcd->bsgd', pooled, w_grp.astype(jnp.float32))
    return mixed.reshape(B, S, POOL_WIDTH) * scale.astype(jnp.float32)


def setup_inputs(seed: int = 0) -> dict:
    key = jax.random.key(seed)
    ks = jax.random.split(key, 12)
    f32 = jnp.float32

    def nrm(k, shape, fan_in):
        return jax.random.normal(k, shape, f32) * (fan_in ** -0.5)

    def gain(k, shape):
        return 1.0 + 0.02 * jax.random.normal(k, shape, f32)

    return {
        "x": jax.random.normal(ks[0], (BATCH, SEQ, D_MODEL), f32),
        "norm_mix_g": gain(ks[1], (DEPTH, D_MODEL)),
        "w_in": nrm(ks[2], (DEPTH, D_MODEL, N_IN), D_MODEL),
        "w_att_out": nrm(ks[3], (DEPTH, ATT_MERGED, D_MODEL), ATT_MERGED),
        "w_pool_grp": nrm(ks[4], (DEPTH, len(POOL_WINDOWS), POOL_GROUP_WIDTH, POOL_GROUP_WIDTH),
                          POOL_GROUP_WIDTH),
        "pool_scale": 1.0 + 0.1 * jax.random.normal(ks[5], (DEPTH, POOL_WIDTH), f32),
        "w_pool_out": nrm(ks[6], (DEPTH, POOL_WIDTH, D_MODEL), POOL_WIDTH),
        "w_out": nrm(ks[7], (DEPTH, D_MODEL, D_MODEL), D_MODEL),
        "norm_mlp_g": gain(ks[8], (DEPTH, D_MODEL)),
        "w_mlp_in": nrm(ks[9], (DEPTH, D_MODEL, D_FF), D_MODEL),
        "w_mlp_out": nrm(ks[10], (DEPTH, D_FF, D_MODEL), D_FF),
        "norm_final_g": gain(ks[11], (D_MODEL,)),
    }


def reference(x, norm_mix_g, w_in, w_att_out, w_pool_grp, pool_scale, w_pool_out, w_out,
              norm_mlp_g, w_mlp_in, w_mlp_out, norm_final_g):
    dt = x.dtype
    offs = np.cumsum([ATT_WIDTH, ATT_WIDTH, ATT_WIDTH, POOL_WIDTH, D_MODEL]).tolist()
    h = x
    for l in range(DEPTH):
        u = _rmsnorm(h, norm_mix_g[l])
        z = jnp.einsum('bsd,dn->bsn', u, w_in[l])
        q, k, v, pz, ga, gp = jnp.split(z, offs, axis=-1)
        a = _attention_branch(q, k, v).astype(dt)
        p = _pool_branch(pz, w_pool_grp[l], pool_scale[l]).astype(dt)
        merged = (jax.nn.sigmoid(ga) * jnp.einsum('bsc,cd->bsd', a, w_att_out[l])
                  + jax.nn.sigmoid(gp) * jnp.einsum('bsc,cd->bsd', p, w_pool_out[l]))
        h = h + jnp.einsum('bsd,de->bse', merged, w_out[l])
        m = _rmsnorm(h, norm_mlp_g[l])
        hid = jnp.square(jax.nn.relu(jnp.einsum('bsd,df->bsf', m, w_mlp_in[l])))
        h = h + jnp.einsum('bsf,fd->bsd', hid, w_mlp_out[l])
    return _rmsnorm(h, norm_final_g)
```

```cpp
#include <hip/hip_runtime.h>
#include <cstdio>
#include <cstdint>

#define LAS __attribute__((address_space(3)))
typedef unsigned short bf16_t;
typedef short bf16x8 __attribute__((ext_vector_type(8)));
typedef float f32x4 __attribute__((ext_vector_type(4)));
typedef float f32x16 __attribute__((ext_vector_type(16)));
typedef unsigned u32x4 __attribute__((ext_vector_type(4)));
typedef unsigned u32x2 __attribute__((ext_vector_type(2)));
typedef short s16x4 __attribute__((ext_vector_type(4)));
typedef float f32x2_t __attribute__((ext_vector_type(2)));
typedef __bf16 bf16x2_t __attribute__((ext_vector_type(2)));

__device__ __forceinline__ unsigned cvtpk(float lo, float hi) { f32x2_t v = {lo, hi}; bf16x2_t b = __builtin_convertvector(v, bf16x2_t); return __builtin_bit_cast(unsigned, b); }
__device__ __forceinline__ float bflo(unsigned v) { return __uint_as_float(v << 16); }
__device__ __forceinline__ float bfhi(unsigned v) { return __uint_as_float(v & 0xffff0000u); }

constexpr int S = 16384, DM = 1024, NIN = 5120, FF = 4096, AM = 256, PW = 768;
constexpr float EPS = 1e-6f;
constexpr float LOG2E = 1.4426950408889634f;
constexpr float C2 = 0.125f * LOG2E;
constexpr int NWAVES = 8;
constexpr int LDS_BYTES = 147456 + 256;

constexpr size_t KiB = 1024, MiB = 1024 * 1024;
constexpr size_t WS_SSQ = 0;
constexpr size_t WS_BAR = 64 * KiB, BAR_BYTES = 32 * KiB;
constexpr size_t WS_CNT = WS_BAR + 16 * KiB;
constexpr size_t WS_SSQ2 = 128 * KiB;
constexpr size_t WS_WIN = 256 * KiB;
constexpr size_t WS_WCAT = WS_WIN + 10 * MiB;
constexpr size_t WS_WGRP = WS_WCAT + 2 * MiB;
constexpr size_t WS_WOUT = WS_WGRP + 1152 * KiB;
constexpr size_t WS_W1 = WS_WOUT + 2 * MiB;
constexpr size_t WS_W2 = WS_W1 + 8 * MiB;
constexpr size_t WS_Z = 32256 * KiB;
constexpr size_t WS_HID = WS_Z;
constexpr size_t WS_HB = WS_Z + 128 * MiB;
constexpr size_t WS_U = WS_Z + 160 * MiB;
constexpr size_t WS_AP = WS_U;
constexpr size_t WS_MG = WS_U + 32 * MiB;
constexpr size_t WS_WPOS = WS_MG;
constexpr size_t WS_END = WS_MG + 32 * MiB;
static_assert(WS_W2 + 8 * MiB <= WS_Z && WS_END <= 256 * MiB, "ws map");
constexpr size_t DO_OG = 0, DO_POOLED = 24 * MiB, DO_LSE = 48 * MiB;

namespace pg8 {
constexpr int BM = 256, BK = 64, HALF = 128, HTB = HALF * BK * 2, STAGE_BYTES = 8 * HTB, NXCD = 8, WGM = 4;
__host__ __device__ __forceinline__ int lds_byte(int r, int c) { const int st = (r >> 4) * 2 + (c >> 5), rr = r & 15, cc = c & 31, ob = rr * 64 + cc * 2; return st * 1024 + (ob ^ (((ob >> 9) & 1) << 5)); }
__host__ __device__ __forceinline__ void stage_rc(int b, int& R, int& C) { const int st = b / 1024, sb = b % 1024, swz = sb ^ (((sb >> 9) & 1) << 5); R = (st >> 1) * 16 + swz / 64; C = (st & 1) * 32 + (swz % 64) / 2; }
__host__ __device__ __forceinline__ int perm32(int rho) { const int n = rho >> 4, i = rho & 15; return 8 * (i >> 2) + 4 * n + (i & 3); }

struct Unit { int pm, pn; };
struct Gemm { const bf16_t* A; const bf16_t* Bt; };

struct StaticOrder {
    int nM, nN, nwg, G, c;
    __host__ __device__ void init(int M, int N, int G_, int c_) { nM = M / BM; nN = N / BM; nwg = nM * nN; G = G_; c = c_; }
    __host__ __device__ bool next(int i, Unit& u) const {
        const long L = (long)i * G + c; if (L >= nwg) return false;
        int wgid = (int)L; { const int q = nwg / NXCD, r = nwg % NXCD, xcd = wgid % NXCD, off = wgid / NXCD; wgid = (xcd < r ? xcd * (q + 1) : r * (q + 1) + (xcd - r) * q) + off; }
        const int nig = WGM * nN, gid = wgid / nig, fm = gid * WGM, gsz = (nM - fm) < WGM ? (nM - fm) : WGM;
        u.pm = fm + ((wgid % nig) % gsz); u.pn = (wgid % nig) / gsz; return true;
    }
};

#define ACC_T const f32x4 (&acc)[2][2][4][2]

struct EpiZ {
    static constexpr bool PERM = true; static constexpr int MID_T = -1;
    bf16_t* Z;
    __device__ __forceinline__ void operator()(ACC_T, const Unit& u, int wr, int wc, int fr, int fq) const {
        const int row0 = u.pm * BM + wr * 64 + fr, col0 = u.pn * BM + wc * 32 + 8 * fq;
        const int mode = u.pn < 3 ? 1 : (u.pn >= 12 ? 2 : 0);
#pragma unroll
        for (int ai = 0; ai < 2; ++ai)
#pragma unroll
            for (int m = 0; m < 4; ++m) { const int row = row0 + ai * HALF + m * 16; bf16_t* rowp = Z + (size_t)row * NIN + col0;
                f32x4 v[2][2];
#pragma unroll
                for (int bj = 0; bj < 2; ++bj) { v[bj][0] = acc[ai][bj][m][0]; v[bj][1] = acc[ai][bj][m][1]; }
                if (mode == 1) {
#pragma unroll
                    for (int bj = 0; bj < 2; ++bj) { v[bj][0] = v[bj][0] * C2; v[bj][1] = v[bj][1] * C2; } }
                if (mode == 2) {
#pragma unroll
                    for (int n = 0; n < 2; ++n)
#pragma unroll
                        for (int e = 0; e < 4; ++e) { const float ea = __builtin_amdgcn_exp2f(-LOG2E * v[0][n][e]), ep = __builtin_amdgcn_exp2f(-LOG2E * v[1][n][e]);
                            const float ia = __builtin_amdgcn_rcpf(1.f + ea), sp = fmaxf(__builtin_amdgcn_rcpf(1.f + ep), 1e-30f);
                            v[0][n][e] = fminf(1.f + ep, 1e30f) * ia; v[1][n][e] = sp; } }
#pragma unroll
                for (int bj = 0; bj < 2; ++bj) { u32x4 w; w.x = cvtpk(v[bj][0][0], v[bj][0][1]); w.y = cvtpk(v[bj][0][2], v[bj][0][3]); w.z = cvtpk(v[bj][1][0], v[bj][1][1]); w.w = cvtpk(v[bj][1][2], v[bj][1][3]);
                    *(u32x4*)(rowp + bj * HALF) = w; } }
    }
};
struct EpiWcomb {
    static constexpr bool PERM = true; static constexpr int MID_T = -1;
    bf16_t* W;
    __device__ __forceinline__ void operator()(ACC_T, const Unit& u, int wr, int wc, int fr, int fq) const {
        const int row0 = u.pm * BM + wr * 64 + fr, col0 = u.pn * BM + wc * 32 + 8 * fq;
#pragma unroll
        for (int ai = 0; ai < 2; ++ai)
#pragma unroll
            for (int m = 0; m < 4; ++m) { bf16_t* rowp = W + (size_t)(row0 + ai * HALF + m * 16) * DM + AM + col0;
#pragma unroll
                for (int bj = 0; bj < 2; ++bj) { const f32x4 v0 = acc[ai][bj][m][0], v1 = acc[ai][bj][m][1];
                    u32x4 w; w.x = cvtpk(v0[0], v0[1]); w.y = cvtpk(v0[2], v0[3]); w.z = cvtpk(v1[0], v1[1]); w.w = cvtpk(v1[2], v1[3]);
                    *(u32x4*)(rowp + bj * HALF) = w; } }
    }
};
struct EpiMerged {
    static constexpr bool PERM = true; static constexpr int MID_T = 4;
    const bf16_t* Z; bf16_t* MG;
    __device__ __forceinline__ void mid(f32x4 (&acc)[2][2][4][2], const Unit& u, int wr, int wc, int fr, int fq) const {
        unsigned off = (unsigned)((u.pm * BM + wr * 64 + fr) * NIN + 3072 + 512 * u.pn + wc * 32 + 8 * fq) * 2u; asm volatile("" : "+v"(off));
        const char* zb = (const char*)Z;
#pragma unroll
        for (int ai = 0; ai < 2; ++ai) {
            u32x4 rt[4][2];
#pragma unroll
            for (int m = 0; m < 4; ++m)
#pragma unroll
                for (int bj = 0; bj < 2; ++bj) rt[m][bj] = *(const u32x4*)(zb + off + (unsigned)((ai * HALF + m * 16) * NIN * 2) + (256 * bj) * 2);
            __builtin_amdgcn_sched_barrier(0);
#pragma unroll
            for (int m = 0; m < 4; ++m)
#pragma unroll
                for (int bj = 0; bj < 2; ++bj)
#pragma unroll
                    for (int q = 0; q < 4; ++q) { acc[ai][bj][m][q >> 1][2 * (q & 1)] *= bflo(rt[m][bj][q]); acc[ai][bj][m][q >> 1][2 * (q & 1) + 1] *= bfhi(rt[m][bj][q]); }
        }
    }
    __device__ __forceinline__ void operator()(ACC_T, const Unit& u, int wr, int wc, int fr, int fq) const {
        const unsigned rc = (unsigned)(u.pm * BM + wr * 64 + fr), cc = (unsigned)(u.pn * BM + wc * 32 + 8 * fq);
        unsigned off = (rc * NIN + 3072 + 128 + 512 * u.pn + wc * 32 + 8 * fq) * 2u, offo = (rc * DM + cc) * 2u; asm volatile("" : "+v"(off), "+v"(offo));
        const char* zb = (const char*)Z; char* ob = (char*)MG;
        u32x4 gpv[2][4][2];
#pragma unroll
        for (int ai = 0; ai < 2; ++ai)
#pragma unroll
            for (int m = 0; m < 4; ++m)
#pragma unroll
                for (int bj = 0; bj < 2; ++bj) gpv[ai][m][bj] = *(const u32x4*)(zb + off + (unsigned)((ai * HALF + m * 16) * NIN * 2) + (256 * bj) * 2);
        __builtin_amdgcn_sched_barrier(0);
#pragma unroll
        for (int ai = 0; ai < 2; ++ai)
#pragma unroll
            for (int m = 0; m < 4; ++m) { const unsigned oo = offo + (unsigned)((ai * HALF + m * 16) * DM * 2);
#pragma unroll
                for (int bj = 0; bj < 2; ++bj) { const u32x4 gp = gpv[ai][m][bj];
                    const f32x4 v0 = acc[ai][bj][m][0], v1 = acc[ai][bj][m][1];
                    u32x4 w; w.x = cvtpk(v0[0] * bflo(gp.x), v0[1] * bfhi(gp.x)); w.y = cvtpk(v0[2] * bflo(gp.y), v0[3] * bfhi(gp.y));
                    w.z = cvtpk(v1[0] * bflo(gp.z), v1[1] * bfhi(gp.z)); w.w = cvtpk(v1[2] * bflo(gp.w), v1[3] * bfhi(gp.w));
                    *(u32x4*)(ob + oo + bj * HALF * 2) = w; } }
    }
};
struct EpiWout {
    static constexpr bool PERM = true; static constexpr int MID_T = -1;
    const float* X; bf16_t* HB; float* ssq; LAS float* red;
    __device__ __forceinline__ void operator()(ACC_T, const Unit& u, int wr, int wc, int fr, int fq) const {
        const int row0 = u.pm * BM + wr * 64 + fr, col0 = u.pn * BM + wc * 32 + 8 * fq;
        float svall[8];
#pragma unroll
        for (int ai = 0; ai < 2; ++ai) {
            f32x4 xa[4][2][2];
#pragma unroll
            for (int m = 0; m < 4; ++m)
#pragma unroll
                for (int bj = 0; bj < 2; ++bj) { const float* xp = X + (size_t)(row0 + ai * HALF + m * 16) * DM + col0 + bj * HALF; xa[m][bj][0] = *(const f32x4*)xp; xa[m][bj][1] = *(const f32x4*)(xp + 4); }
            __builtin_amdgcn_sched_barrier(0);
            float sv[4];
#pragma unroll
            for (int m = 0; m < 4; ++m) { const size_t row = (size_t)(row0 + ai * HALF + m * 16); float s = 0.f;
#pragma unroll
                for (int bj = 0; bj < 2; ++bj) {
                    const f32x4 v0 = xa[m][bj][0] + acc[ai][bj][m][0], v1 = xa[m][bj][1] + acc[ai][bj][m][1];
                    u32x4 w; w.x = cvtpk(v0[0], v0[1]); w.y = cvtpk(v0[2], v0[3]); w.z = cvtpk(v1[0], v1[1]); w.w = cvtpk(v1[2], v1[3]);
                    *(u32x4*)(HB + row * DM + col0 + bj * HALF) = w;
                    s += (v0[0] * v0[0] + v0[1] * v0[1]) + (v0[2] * v0[2] + v0[3] * v0[3]) + (v1[0] * v1[0] + v1[1] * v1[1]) + (v1[2] * v1[2] + v1[3] * v1[3]); }
                s += __shfl_xor(s, 16); s += __shfl_xor(s, 32); sv[m] = s; }
#pragma unroll
            for (int m = 0; m < 4; ++m) svall[ai * 4 + m] = sv[m];
        }
        if (fq == 0) {
#pragma unroll
            for (int i = 0; i < 8; ++i) red[wc * 256 + (i >> 2) * HALF + wr * 64 + (i & 3) * 16 + fr] = svall[i]; }
        asm volatile("s_waitcnt lgkmcnt(0)" ::: "memory"); __builtin_amdgcn_s_barrier(); asm volatile("" ::: "memory");
        const int t = (wr * 4 + wc) * 64 + fq * 16 + fr;
        if (t < 256) __hip_atomic_fetch_add(ssq + (size_t)u.pm * BM + t, (red[t] + red[256 + t]) + (red[512 + t] + red[768 + t]), __ATOMIC_RELAXED, __HIP_MEMORY_SCOPE_AGENT);
    }
};
struct EpiUp {
    static constexpr bool PERM = true; static constexpr int MID_T = -1;
    bf16_t* HID; const float* ssq;
    __device__ __forceinline__ void operator()(ACC_T, const Unit& u, int wr, int wc, int fr, int fq) const {
        const int row0 = u.pm * BM + wr * 64 + fr, col0 = u.pn * BM + wc * 32 + 8 * fq;
#pragma unroll
        for (int ai = 0; ai < 2; ++ai)
#pragma unroll
            for (int m = 0; m < 4; ++m) { const size_t row = (size_t)(row0 + ai * HALF + m * 16);
                const float rs = 1.0f / sqrtf(ssq[row] * (1.0f / DM) + EPS);
                bf16_t* rowp = HID + row * FF + col0;
#pragma unroll
                for (int bj = 0; bj < 2; ++bj) { f32x4 v0 = acc[ai][bj][m][0] * rs, v1 = acc[ai][bj][m][1] * rs;
#pragma unroll
                    for (int e = 0; e < 4; ++e) { const float a = fmaxf(v0[e], 0.f), b = fmaxf(v1[e], 0.f); v0[e] = a * a; v1[e] = b * b; }
                    u32x4 w; w.x = cvtpk(v0[0], v0[1]); w.y = cvtpk(v0[2], v0[3]); w.z = cvtpk(v1[0], v1[1]); w.w = cvtpk(v1[2], v1[3]);
                    *(u32x4*)(rowp + bj * HALF) = w; } }
    }
};
struct EpiDownNorm {
    static constexpr bool PERM = true; static constexpr int MID_T = -1;
    const bf16_t* HB; float* O; float* ssq2; unsigned* cnt; const float* g3; LAS float* red;
    __device__ __forceinline__ void operator()(f32x4 (&acc)[2][2][4][2], const Unit& u, int wr, int wc, int fr, int fq) const {
        const unsigned rc = (unsigned)(u.pm * BM + wr * 64 + fr), cc = (unsigned)(u.pn * BM + wc * 32 + 8 * fq);
        unsigned offh = (rc * DM + cc) * 2u; asm volatile("" : "+v"(offh));
        const char* hb = (const char*)HB; char* ob = (char*)O;
        {
            u32x4 hv[2][4][2];
#pragma unroll
            for (int ai = 0; ai < 2; ++ai)
#pragma unroll
                for (int m = 0; m < 4; ++m)
#pragma unroll
                    for (int bj = 0; bj < 2; ++bj) hv[ai][m][bj] = *(const u32x4*)(hb + offh + (unsigned)((ai * HALF + m * 16) * DM * 2) + bj * HALF * 2);
            __builtin_amdgcn_sched_barrier(0);
            float sv[8];
#pragma unroll
            for (int ai = 0; ai < 2; ++ai)
#pragma unroll
                for (int m = 0; m < 4; ++m) { float s = 0.f;
#pragma unroll
                    for (int bj = 0; bj < 2; ++bj) { const u32x4 h4 = hv[ai][m][bj];
                        const f32x4 v0 = (f32x4){bflo(h4.x), bfhi(h4.x), bflo(h4.y), bfhi(h4.y)} + acc[ai][bj][m][0], v1 = (f32x4){bflo(h4.z), bfhi(h4.z), bflo(h4.w), bfhi(h4.w)} + acc[ai][bj][m][1];
                        acc[ai][bj][m][0] = v0; acc[ai][bj][m][1] = v1;
                        s += (v0[0] * v0[0] + v0[1] * v0[1]) + (v0[2] * v0[2] + v0[3] * v0[3]) + (v1[0] * v1[0] + v1[1] * v1[1]) + (v1[2] * v1[2] + v1[3] * v1[3]); }
                    s += __shfl_xor(s, 16); s += __shfl_xor(s, 32); sv[ai * 4 + m] = s; }
            if (fq == 0) {
#pragma unroll
                for (int i = 0; i < 8; ++i) red[wc * 256 + (i >> 2) * HALF + wr * 64 + (i & 3) * 16 + fr] = sv[i]; }
            asm volatile("s_waitcnt lgkmcnt(0)" ::: "memory"); __builtin_amdgcn_s_barrier(); asm volatile("" ::: "memory");
            if (wr == 0 && wc == 0) { const int l64 = fq * 16 + fr;
#pragma unroll
                for (int q = 0; q < 4; ++q) { const int t = q * 64 + l64;
                    __hip_atomic_fetch_add(ssq2 + (size_t)u.pm * BM + t, (red[t] + red[256 + t]) + (red[512 + t] + red[768 + t]), __ATOMIC_RELAXED, __HIP_MEMORY_SCOPE_AGENT); }
                asm volatile("s_waitcnt vmcnt(0)" ::: "memory"); }
        }
        unsigned* pc = cnt + 64 * u.pm;
        f32x4 gv[2][2];
#pragma unroll
        for (int bj = 0; bj < 2; ++bj) { gv[bj][0] = *(const f32x4*)(g3 + cc + bj * HALF); gv[bj][1] = *(const f32x4*)(g3 + cc + bj * HALF + 4); }
        if (wr == 0 && wc == 0) {
            if (fr == 0 && fq == 0) __hip_atomic_fetch_add(pc, 1u, __ATOMIC_RELAXED, __HIP_MEMORY_SCOPE_AGENT);
            unsigned sp = 0u;
            while (__hip_atomic_load(pc, __ATOMIC_RELAXED, __HIP_MEMORY_SCOPE_AGENT) < 4u) { __builtin_amdgcn_s_sleep(2); if (++sp > (1u << 20)) break; }
        }
        asm volatile("s_waitcnt vmcnt(0) lgkmcnt(0)" ::: "memory"); __builtin_amdgcn_s_barrier(); asm volatile("" ::: "memory");
        float rsv[8];
#pragma unroll
        for (int i = 0; i < 8; ++i) rsv[i] = __hip_atomic_load(ssq2 + rc + ((i >> 2) * HALF + (i & 3) * 16), __ATOMIC_RELAXED, __HIP_MEMORY_SCOPE_AGENT);
        __builtin_amdgcn_sched_barrier(0);
#pragma unroll
        for (int ai = 0; ai < 2; ++ai)
#pragma unroll
            for (int m = 0; m < 4; ++m) { const unsigned ro = offh + (unsigned)((ai * HALF + m * 16) * DM * 2);
                const float rs = 1.0f / sqrtf(rsv[ai * 4 + m] * (1.0f / DM) + EPS);
#pragma unroll
                for (int bj = 0; bj < 2; ++bj) { const f32x4 v0 = acc[ai][bj][m][0], v1 = acc[ai][bj][m][1];
                    float* op = (float*)(ob + 2 * ro + bj * HALF * 4);
                    *(f32x4*)op = v0 * rs * gv[bj][0]; *(f32x4*)(op + 4) = v1 * rs * gv[bj][1]; } }
    }
};

template <class Epi, class Sched, int K, int KLOOP, int KOFF, bool ALIGN_EPI = true>
__device__ __forceinline__ void gemm_phase(LAS unsigned char* lds, const Gemm g, const Sched& Sc, const Epi& E, const int wid) {
    int lane = __builtin_amdgcn_mbcnt_hi(~0u, __builtin_amdgcn_mbcnt_lo(~0u, 0u)); asm volatile("" : "+v"(lane));
    const int tid = wid * 64 + lane, wr = wid >> 2, wc = wid & 3, fr = lane & 15, fq = lane >> 4;
    constexpr int nt = KLOOP / BK;
    unsigned voffA[2], voffB[2];
#pragma unroll
    for (int i = 0; i < 2; ++i) { int R, C; stage_rc(tid * 16 + i * 8192, R, C); const int Rb = Epi::PERM ? ((R & ~31) + perm32(R & 31)) : R;
        voffA[i] = (unsigned)(R * K + C) * 2u; voffB[i] = (unsigned)(Rb * K + C) * 2u; }
    constexpr size_t kstep = (size_t)(BK * 2);
    constexpr size_t hstep = (size_t)HALF * K * 2;
    constexpr size_t tstep = 2 * hstep;
    constexpr size_t kofs = (size_t)KOFF * 2;
    const unsigned ldsw = (unsigned)wid * 1024u;
    const int aoff = lds_byte(wr * 64 + fr, fq * 8), boff = lds_byte(wc * 32 + fr, fq * 8);
#define PG8_SA(b, h) (((b) * 2 + (h)) * HTB)
#define PG8_SB(b, h) ((4 + (b) * 2 + (h)) * HTB)
#define PG8_STAGE(bufoff, gbase, voff) do { _Pragma("unroll") for (int _i = 0; _i < 2; ++_i) \
        __builtin_amdgcn_global_load_lds((const unsigned*)((const char*)(gbase) + (voff)[_i]), (LAS unsigned*)(lds + (bufoff) + ldsw + _i * 8192), 16, 0, 0); } while (0)
#define PG8_LDA(dst, b, h) do { _Pragma("unroll") for (int m = 0; m < 4; ++m) _Pragma("unroll") for (int k = 0; k < 2; ++k) dst[m][k] = *(const LAS bf16x8*)(lds + PG8_SA(b, h) + aoff + m * 2048 + k * 1024); } while (0)
#define PG8_LDB(dst, b, h) do { _Pragma("unroll") for (int n = 0; n < 2; ++n) _Pragma("unroll") for (int k = 0; k < 2; ++k) dst[n][k] = *(const LAS bf16x8*)(lds + PG8_SB(b, h) + boff + n * 2048 + k * 1024); } while (0)
#define PG8_MMA(ai, bj, At, Bt) do { __builtin_amdgcn_s_setprio(1); _Pragma("unroll") for (int m = 0; m < 4; ++m) _Pragma("unroll") for (int n = 0; n < 2; ++n) _Pragma("unroll") for (int k = 0; k < 2; ++k) \
        acc[ai][bj][m][n] = __builtin_amdgcn_mfma_f32_16x16x32_bf16(Bt[n][k], At[m][k], acc[ai][bj][m][n], 0, 0, 0); __builtin_amdgcn_s_setprio(0); } while (0)
#define PG8_WAIT_V(n) asm volatile("s_waitcnt vmcnt(" #n ")" ::: "memory")
#define PG8_WAIT_L(n) asm volatile("s_waitcnt lgkmcnt(" #n ")" ::: "memory")
#define PG8_BAR __builtin_amdgcn_s_barrier()
#define PG8_SCHED __builtin_amdgcn_sched_barrier(0)
    Unit cur, nxt; int ui = 0;
    if (!Sc.next(0, cur)) return;
    f32x4 acc[2][2][4][2];
#pragma unroll
    for (int a = 0; a < 2; ++a)
#pragma unroll
        for (int b = 0; b < 2; ++b)
#pragma unroll
            for (int m = 0; m < 4; ++m)
#pragma unroll
                for (int n = 0; n < 2; ++n) acc[a][b][m][n] = (f32x4){0.f, 0.f, 0.f, 0.f};
    bf16x8 At[4][2], B0[2][2], B1[2][2];
    const char* cA = (const char*)g.A + (size_t)cur.pm * tstep + (size_t)cur.pn * kofs; const char* cB = (const char*)g.Bt + (size_t)cur.pn * tstep + (size_t)cur.pn * kofs;
    PG8_STAGE(PG8_SB(0, 0), cB, voffB); PG8_STAGE(PG8_SB(0, 1), cB + hstep, voffB); PG8_STAGE(PG8_SA(0, 0), cA, voffA); PG8_STAGE(PG8_SA(0, 1), cA + hstep, voffA);
    if (wr == 1) PG8_BAR;
    PG8_WAIT_V(2); PG8_BAR;
    PG8_STAGE(PG8_SB(1, 0), cB + kstep, voffB); PG8_STAGE(PG8_SA(1, 0), cA + kstep, voffA); PG8_STAGE(PG8_SB(1, 1), cB + hstep + kstep, voffB);
    PG8_WAIT_V(6); PG8_BAR;
    for (;;) {
        const bool has_next = Sc.next(ui + 1, nxt);
        const char* nA = has_next ? (const char*)g.A + (size_t)nxt.pm * tstep + (size_t)nxt.pn * kofs : cA; const char* nB = has_next ? (const char*)g.Bt + (size_t)nxt.pn * tstep + (size_t)nxt.pn * kofs : cB;
#pragma unroll 1
        for (int t = 0; t < nt; t += 2) {
            const bool last = (t == nt - 2);
            const char* a1 = cA + (size_t)(t + 1) * kstep;
            const char* a2 = last ? nA : cA + (size_t)(t + 2) * kstep; const char* b2 = last ? nB : cB + (size_t)(t + 2) * kstep;
            const char* a3 = a2 + kstep; const char* b3 = b2 + kstep;
            if constexpr (Epi::MID_T > 0) { if (t == Epi::MID_T) E.mid(acc, cur, wr, wc, fr, fq); }
            PG8_LDB(B0, 0, 0); PG8_LDB(B1, 0, 1); PG8_SCHED; PG8_LDA(At, 0, 0); PG8_STAGE(PG8_SA(1, 1), a1 + hstep, voffA);
            PG8_WAIT_V(8); PG8_WAIT_L(0); PG8_BAR; PG8_MMA(0, 0, At, B0); PG8_MMA(0, 1, At, B1); PG8_BAR; PG8_SCHED;
            PG8_LDA(At, 0, 1); PG8_STAGE(PG8_SB(0, 0), b2, voffB); PG8_STAGE(PG8_SB(0, 1), b2 + hstep, voffB); PG8_STAGE(PG8_SA(0, 0), a2, voffA);
            PG8_WAIT_V(8); PG8_WAIT_L(0); PG8_BAR; PG8_MMA(1, 0, At, B0); PG8_MMA(1, 1, At, B1); PG8_BAR; PG8_SCHED;
            PG8_LDB(B0, 1, 0); PG8_LDB(B1, 1, 1); PG8_SCHED; PG8_LDA(At, 1, 0); PG8_STAGE(PG8_SA(0, 1), a2 + hstep, voffA);
            PG8_WAIT_V(8); PG8_WAIT_L(0); PG8_BAR; PG8_MMA(0, 0, At, B0); PG8_MMA(0, 1, At, B1); PG8_BAR; PG8_SCHED;
            PG8_LDA(At, 1, 1); PG8_STAGE(PG8_SB(1, 0), b3, voffB); PG8_STAGE(PG8_SB(1, 1), b3 + hstep, voffB); PG8_STAGE(PG8_SA(1, 0), a3, voffA);
            PG8_WAIT_V(8); PG8_WAIT_L(0); PG8_BAR; PG8_MMA(1, 0, At, B0); PG8_MMA(1, 1, At, B1); PG8_BAR; PG8_SCHED;
        }
        if constexpr (ALIGN_EPI) { if (wr == 0) PG8_BAR; }
        E(acc, cur, wr, wc, fr, fq);
        if (!has_next) break;
#pragma unroll
        for (int a = 0; a < 2; ++a)
#pragma unroll
            for (int b = 0; b < 2; ++b)
#pragma unroll
                for (int m = 0; m < 4; ++m)
#pragma unroll
                    for (int n = 0; n < 2; ++n) acc[a][b][m][n] = (f32x4){0.f, 0.f, 0.f, 0.f};
        cur = nxt; cA = nA; cB = nB; ++ui;
        if constexpr (ALIGN_EPI) { if (wr == 1) PG8_BAR; }
    }
    PG8_WAIT_V(0);
    if constexpr (!ALIGN_EPI) { if (wr == 0) PG8_BAR; }
    PG8_BAR;
#undef PG8_SA
#undef PG8_SB
#undef PG8_STAGE
#undef PG8_LDA
#undef PG8_LDB
#undef PG8_MMA
#undef PG8_WAIT_V
#undef PG8_WAIT_L
#undef PG8_BAR
#undef PG8_SCHED
}
}

__device__ __forceinline__ unsigned f2bf(float f) { unsigned u = __builtin_bit_cast(unsigned, f); return (u + 0x7fffu + ((u >> 16) & 1u)) >> 16; }
__device__ __forceinline__ unsigned pk2(float lo, float hi) { return f2bf(lo) | (f2bf(hi) << 16); }
__device__ __forceinline__ float wave_sum(float v) {
#pragma unroll
    for (int o = 1; o < 64; o <<= 1) v += __shfl_xor(v, o);
    return v;
}
__device__ __forceinline__ void transpose_item(const float* W, int N, bf16_t* WT, int ldt, int row_off, int col_off, const float* kscale, LAS float* scr, int item, int lane) {
    const int nblk = N / 32, kb = item / nblk, nb = item % nblk, k0 = 64 * kb, n0 = 32 * nb;
    float tv[32];
#pragma unroll
    for (int i = 0; i < 32; ++i) { const int kk = 2 * i + (lane >> 5); tv[i] = __builtin_nontemporal_load(&W[(size_t)(k0 + kk) * N + n0 + (lane & 31)]); }
    if (kscale) {
#pragma unroll
        for (int i = 0; i < 32; ++i) tv[i] *= kscale[k0 + 2 * i + (lane >> 5)]; }
#pragma unroll
    for (int i = 0; i < 32; ++i) scr[(2 * i + (lane >> 5)) * 33 + (lane & 31)] = tv[i];
    asm volatile("s_waitcnt lgkmcnt(0)" ::: "memory");
    const int c = lane & 7;
#pragma unroll
    for (int j = 0; j < 4; ++j) { const int n = (lane >> 3) + 8 * j; const LAS float* s = scr + (8 * c) * 33 + n;
        u32x4 o; o.x = pk2(s[0 * 33], s[1 * 33]); o.y = pk2(s[2 * 33], s[3 * 33]); o.z = pk2(s[4 * 33], s[5 * 33]); o.w = pk2(s[6 * 33], s[7 * 33]);
        *(u32x4*)(WT + (size_t)(row_off + n0 + n) * ldt + col_off + k0 + 8 * c) = o; }
    asm volatile("s_waitcnt lgkmcnt(0)" ::: "memory");
}

__device__ __forceinline__ int crow(int r, int hi) { return (r & 3) + 8 * (r >> 2) + 4 * hi; }
#define MFMA32(a, b, c) __builtin_amdgcn_mfma_f32_32x32x16_bf16((a), (b), (c), 0, 0, 0)
constexpr int VROW = 144;

constexpr int KIMG_OFF = 0, VIMG_OFF = 384 * VROW, OSTG_OFF = 2 * 384 * VROW;
__device__ __forceinline__ void attn_stage_load(const bf16_t* __restrict__ Z, int wu, int wave, int lane, u32x4 (&kg)[2][4], u32x4 (&vg)[2][4]) {
    const int g = wu >> 8, rem = wu & 255;
    const int dsh = 2 * g, d = 1 << dsh, nwsh = 6 - dsh;
    const int qbw = rem & ((1 << nwsh) - 1), hr = rem >> nwsh;
    const int r = hr & (d - 1), hh = hr >> dsh, h = g * 4 + hh;
    const int i0wg = qbw * 256;
    const char* Zc = (const char*)Z;
    const int vstep = (8 * d) * (NIN * 2);
#pragma unroll
    for (int jj = 0; jj < 2; ++jj) { const int j = wave + 8 * jj;
        if (j < 12 && i0wg - 128 + 32 * j >= 0) {
            const unsigned off = (unsigned)(((i0wg - 128 + 32 * j + (lane >> 3)) * d + r) * (NIN * 2) + (768 + h * 64 + (lane & 7) * 8) * 2);
#pragma unroll
            for (int i = 0; i < 4; ++i) { kg[jj][i] = *(const u32x4*)(Zc + off + i * vstep); vg[jj][i] = *(const u32x4*)(Zc + off + 1536 + i * vstep); } } }
}
__device__ __forceinline__ void attn_wg_unit(const bf16_t* __restrict__ Z, bf16_t* __restrict__ OG, float* __restrict__ LSE, int wu, int wu_next, u32x4 (&kg)[2][4], u32x4 (&vg)[2][4], LAS unsigned char* lds, int wave, int lane) {
    const int g = wu >> 8, rem = wu & 255;
    const int dsh = 2 * g, d = 1 << dsh, nwsh = 6 - dsh;
    const int qbw = rem & ((1 << nwsh) - 1), hr = rem >> nwsh;
    const int r = hr & (d - 1), hh = hr >> dsh, h = g * 4 + hh;
    const int ql = lane & 31, hi = lane >> 5;
    const int i0wg = qbw * 256, i0 = i0wg + 32 * wave;
    const float slope2 = exp2f(-8.0f * (float)(h + 1) / 12.0f) * LOG2E * (float)d;
    const char* Zc = (const char*)Z;
    LAS unsigned char* kimg = lds + KIMG_OFF; LAS unsigned char* vimg = lds + VIMG_OFF; LAS unsigned char* ostg = lds + OSTG_OFF + wave * (32 * VROW);
#pragma unroll
    for (int jj = 0; jj < 2; ++jj) { const int j = wave + 8 * jj;
        if (j < 12 && i0wg - 128 + 32 * j >= 0) {
            const int ro = (32 * j + (lane >> 3)) * VROW + (lane & 7) * 16;
#pragma unroll
            for (int i = 0; i < 4; ++i) { *(LAS u32x4*)(kimg + ro + 8 * i * VROW) = kg[jj][i]; *(LAS u32x4*)(vimg + ro + 8 * i * VROW) = vg[jj][i]; } } }
    const unsigned tq = (unsigned)((i0 + ql) * d + r);
    bf16x8 qf[4];
    { const char* qp = Zc + tq * (unsigned)(NIN * 2) + (unsigned)((h * 64 + hi * 8) * 2);
#pragma unroll
      for (int d0 = 0; d0 < 4; ++d0) qf[d0] = *(const bf16x8*)(qp + d0 * 32); }
    const int kt0 = i0 >= 128 ? 0 : ((128 - i0) >> 5);
    f32x16 cb, cb0, cb4;
#pragma unroll
    for (int i = 0; i < 16; ++i) { const int ci = (i & 3) + 8 * (i >> 2) + 4 * hi; const float bv = -slope2 * (float)(128 + ql - ci);
        cb[i] = bv; cb0[i] = (ci >= ql) ? bv : -1e30f; cb4[i] = (ci <= ql) ? bv : -1e30f; }
    __syncthreads();
    if (wu_next >= 0) attn_stage_load(Z, wu_next, wave, lane, kg, vg);
    const LAS unsigned char* kr = kimg + (32 * wave + ql) * VROW + hi * 16;
    const LAS unsigned char* vr = vimg + (32 * wave) * VROW + ((lane >> 4) & 1) * 32 + (lane & 3) * 8 + (((lane & 15) >> 2) + 4 * hi) * VROW;
    f32x16 sc[5];
#pragma unroll
    for (int kt = 0; kt < 5; ++kt) {
        if (kt >= kt0) {
            f32x16 s = (kt == 0) ? cb0 : ((kt == 4) ? cb4 : cb);
#pragma unroll
            for (int d0 = 0; d0 < 4; ++d0) { const bf16x8 kf = *(const LAS bf16x8*)(kr + kt * 32 * VROW + d0 * 32); s = MFMA32(kf, qf[d0], s); }
            sc[kt] = s;
        } else {
#pragma unroll
            for (int i = 0; i < 16; ++i) sc[kt][i] = -1e30f;
        }
    }
    float mrow = -1e30f;
#pragma unroll
    for (int kt = 0; kt < 5; ++kt) { float mt = sc[kt][0];
#pragma unroll
        for (int i = 1; i < 16; ++i) mt = fmaxf(mt, sc[kt][i]);
        mrow = fmaxf(mrow, mt + (float)(32 * kt) * slope2); }
    mrow = fmaxf(mrow, __shfl_xor(mrow, 32));
    f32x16 oT[2];
#pragma unroll
    for (int i = 0; i < 16; ++i) { oT[0][i] = 0.f; oT[1][i] = 0.f; }
    float lrun = 0.f;
#pragma unroll
    for (int kt = 0; kt < 5; ++kt) {
        if (kt >= kt0) {
            const float sh = (float)(32 * kt) * slope2 - mrow;
            float ls = 0.f;
#pragma unroll
            for (int i = 0; i < 16; ++i) { const float pe = __builtin_amdgcn_exp2f(sc[kt][i] + sh); sc[kt][i] = pe; ls += pe; }
            lrun += ls;
#pragma unroll
            for (int j = 0; j < 2; ++j) {
                u32x4 pw; pw.x = cvtpk(sc[kt][8 * j + 0], sc[kt][8 * j + 1]); pw.y = cvtpk(sc[kt][8 * j + 2], sc[kt][8 * j + 3]); pw.z = cvtpk(sc[kt][8 * j + 4], sc[kt][8 * j + 5]); pw.w = cvtpk(sc[kt][8 * j + 6], sc[kt][8 * j + 7]);
                const bf16x8 pb = __builtin_bit_cast(bf16x8, pw);
#pragma unroll
                for (int dt = 0; dt < 2; ++dt) {
                    const s16x4 lo = __builtin_bit_cast(s16x4, __builtin_amdgcn_ds_read_tr16_b64_v4i16((LAS s16x4*)(vr + (32 * kt + 16 * j) * VROW + dt * 64)));
                    const s16x4 hv = __builtin_bit_cast(s16x4, __builtin_amdgcn_ds_read_tr16_b64_v4i16((LAS s16x4*)(vr + (32 * kt + 16 * j + 8) * VROW + dt * 64)));
                    const bf16x8 va = {lo[0], lo[1], lo[2], lo[3], hv[0], hv[1], hv[2], hv[3]};
                    oT[dt] = MFMA32(va, pb, oT[dt]);
                }
            }
        }
    }
    const float ltot = lrun + __shfl_xor(lrun, 32);
    const float inv = 1.0f / ltot;
#pragma unroll
    for (int dt = 0; dt < 2; ++dt)
#pragma unroll
        for (int rq = 0; rq < 4; ++rq) {
            u32x2 wv; wv.x = cvtpk(oT[dt][4 * rq] * inv, oT[dt][4 * rq + 1] * inv); wv.y = cvtpk(oT[dt][4 * rq + 2] * inv, oT[dt][4 * rq + 3] * inv);
            *(LAS u32x2*)(ostg + ql * VROW + (32 * dt + 8 * rq + 4 * hi) * 2) = wv;
        }
    asm volatile("s_waitcnt lgkmcnt(0)" ::: "memory");
#pragma unroll
    for (int i = 0; i < 4; ++i) { const int row = (lane >> 3) + 8 * i;
        const u32x4 ov = *(const LAS u32x4*)(ostg + row * VROW + (lane & 7) * 16);
        *(u32x4*)(OG + ((size_t)g * S + (size_t)((i0 + row) * d + r)) * AM + hh * 64 + (lane & 7) * 8) = ov; }
    if (hi == 0) LSE[((size_t)g * S + tq) * 4 + hh] = mrow + log2f(ltot);
    __syncthreads();
}

__device__ __forceinline__ void pool_half(const unsigned (&v)[31], const bool hi_half, const int wsel, float (&o)[16]) {
    float a[31];
#pragma unroll
    for (int j = 0; j < 31; ++j) a[j] = hi_half ? bfhi(v[j]) : bflo(v[j]);
#pragma unroll
    for (int j = 30; j >= 1; --j) a[j] += a[j - 1];
#pragma unroll
    for (int i = 0; i < 16; ++i) o[i] = a[15 + i];
#pragma unroll
    for (int j = 30; j >= 3; --j) a[j] += a[j - 2];
#pragma unroll
    for (int i = 0; i < 16; ++i) o[i] = (wsel >= 1) ? a[15 + i] : o[i];
#pragma unroll
    for (int j = 30; j >= 7; --j) a[j] += a[j - 4];
#pragma unroll
    for (int i = 0; i < 16; ++i) o[i] = (wsel >= 2) ? a[15 + i] : o[i];
#pragma unroll
    for (int j = 30; j >= 15; --j) a[j] += a[j - 8];
#pragma unroll
    for (int i = 0; i < 16; ++i) o[i] = (wsel >= 3) ? a[15 + i] : o[i];
}
__device__ __forceinline__ void pool_wave_unit(const bf16_t* __restrict__ Z, bf16_t* __restrict__ PO, int pw, int lane) {
    const int cb = pw % 6, c = pw / 6;
    const int col = cb * 128 + 2 * lane;
    const int wsel = col / 192, w = 2 << wsel;
    const int t0 = c * 16;
    const bf16_t* src = Z + 2304 + col;
    unsigned v[31];
#pragma unroll
    for (int j = 0; j < 31; ++j) { const int t = t0 - 15 + j; v[j] = (t >= 0) ? *(const unsigned*)(src + (size_t)t * NIN) : 0u; }
    float o0[16], o1[16];
    pool_half(v, false, wsel, o0);
    pool_half(v, true, wsel, o1);
    const float invw = 1.0f / (float)w;
#pragma unroll
    for (int i = 0; i < 16; ++i) {
        const int t = t0 + i;
        float inv = invw;
        if (t0 == 0) { const int cnt = (t + 1) < w ? (t + 1) : w; inv = 1.0f / (float)cnt; }
        *(unsigned*)(PO + (size_t)t * DM + AM + col) = cvtpk(o0[i] * inv - bflo(v[15 + i]), o1[i] * inv - bfhi(v[15 + i]));
    }
}

#define XB_TMO      128
#define XB_XCNT(j)  (256  + 64 * (j))
#define XB_XSUB(j)  (1280 + 64 * (j))
#define XB_XGEN(j)  (2304 + 64 * (j))
#define XB_TOP      3328
#define XB_TOPGEN   3392
#define XCD_BAR_WORDS 3456
#define XB_SPIN_CAP (1u << 18)
__device__ __forceinline__ unsigned xb_ld(unsigned* p)              { return __hip_atomic_load(p, __ATOMIC_RELAXED, __HIP_MEMORY_SCOPE_AGENT); }
__device__ __forceinline__ unsigned xb_add(unsigned* p, unsigned v) { return __hip_atomic_fetch_add(p, v, __ATOMIC_RELAXED, __HIP_MEMORY_SCOPE_AGENT); }
__device__ __forceinline__ unsigned xb_xcc_id() { return (unsigned)__builtin_amdgcn_s_getreg((3 << 11) | 20) & 0xFu; }
#define XB_SPIN(cond, bar) do { unsigned _sp = 0; while (cond) { __builtin_amdgcn_s_sleep(1); \
    if ((++_sp & 255u) == 0u) { if (xb_ld(&(bar)[XB_TMO])) break; if (_sp > XB_SPIN_CAP) { atomicAdd(&(bar)[XB_TMO], 1u); break; } } } } while (0)
struct XcdBarrier { unsigned* bar; unsigned x; volatile LAS unsigned* st; };
__device__ __forceinline__ void xcd_barrier_complete(unsigned* bar, unsigned x, unsigned& nloc, unsigned& nx) {
    const unsigned G = gridDim.x * gridDim.y * gridDim.z;
    unsigned sum, cnt, mine, sp = 0u;
    for (;;) {
        sum = 0u; cnt = 0u; mine = 0u;
#pragma unroll
        for (unsigned j = 0; j < 16; ++j) { const unsigned c = xb_ld(&bar[XB_XCNT(j)]); sum += c; cnt += (c > 0u) ? 1u : 0u; mine = (j == x) ? c : mine; }
        if (sum == G) break;
        __builtin_amdgcn_s_sleep(1);
        if ((++sp & 255u) == 0u) { if (xb_ld(&bar[XB_TMO])) break; if (sp > XB_SPIN_CAP) { atomicAdd(&bar[XB_TMO], 1u); break; } }
    }
    nloc = mine > 0u ? mine : 1u; nx = cnt > 0u ? cnt : 1u;
}
__device__ __forceinline__ void xcd_barrier(const XcdBarrier& b, const bool leader) {
    asm volatile("s_waitcnt vmcnt(0)" ::: "memory");
    __syncthreads();
    if (leader) {
        unsigned* bar = b.bar;
        __builtin_amdgcn_s_waitcnt(0);
        __builtin_amdgcn_fence(__ATOMIC_ACQUIRE, "agent");
        unsigned nloc = b.st[0], nx = b.st[1];
        if (nloc == 0u) { xcd_barrier_complete(bar, b.x, nloc, nx); b.st[0] = nloc; b.st[1] = nx; }
        const unsigned old = xb_add(&bar[XB_XSUB(b.x)], 1u);
        const unsigned gen = old / nloc;
        if (old + 1u == (gen + 1u) * nloc) {
            __builtin_amdgcn_fence(__ATOMIC_RELEASE, "agent");
            asm volatile("s_waitcnt vmcnt(0)" ::: "memory");
            const unsigned og = xb_add(&bar[XB_TOP], 1u);
            const unsigned tg = og / nx;
            if (og + 1u == (tg + 1u) * nx) xb_add(&bar[XB_TOPGEN], 1u);
            else XB_SPIN(xb_ld(&bar[XB_TOPGEN]) == tg, bar);
            xb_add(&bar[XB_XGEN(b.x)], 1u);
            asm volatile("s_waitcnt vmcnt(0)" ::: "memory");
        } else {
            XB_SPIN(xb_ld(&bar[XB_XGEN(b.x)]) == gen, bar);
            asm volatile("s_waitcnt vmcnt(0)" ::: "memory");
        }
    }
    __syncthreads();
}

#ifndef PROBE_REP
#define PROBE_REP -1
#endif
#ifndef PROBE_SYNCS
#define PROBE_SYNCS 0
#endif
struct Args { const float* in[12]; float* out; unsigned char* ws; int ph_lo, ph_hi; };
constexpr int NPHASE = 8;

__global__ void __launch_bounds__(NWAVES * 64, 2) fwd_megakernel(Args args) {
    extern __shared__ __attribute__((aligned(16))) unsigned char lds_raw[];
    LAS unsigned char* lds = (LAS unsigned char*)lds_raw;
    const int G = gridDim.x, bx = blockIdx.x;
    const int NGW = G * NWAVES;
    const int wave_s = __builtin_amdgcn_readfirstlane((int)threadIdx.x >> 6);
#define FRESH_IDS int lane = __builtin_amdgcn_mbcnt_hi(~0u, __builtin_amdgcn_mbcnt_lo(~0u, 0u)); asm volatile("" : "+v"(lane)); const int wave = wave_s, tid = wave * 64 + lane; const int gw = bx * NWAVES + wave; (void)gw; (void)tid;
    const int lo = args.ph_lo, hi = args.ph_hi;
    unsigned char* ws = args.ws;
    const float* x = args.in[0];
    float* out = args.out;
    float* ssq = (float*)(ws + WS_SSQ); float* ssq2 = (float*)(ws + WS_SSQ2);
    bf16_t* Win_t = (bf16_t*)(ws + WS_WIN); bf16_t* Wcat_t = (bf16_t*)(ws + WS_WCAT); bf16_t* Wgrp_t = (bf16_t*)(ws + WS_WGRP);
    bf16_t* Wout_t = (bf16_t*)(ws + WS_WOUT); bf16_t* W1_t = (bf16_t*)(ws + WS_W1); bf16_t* W2_t = (bf16_t*)(ws + WS_W2);
    bf16_t* Zb = (bf16_t*)(ws + WS_Z); bf16_t* HID = (bf16_t*)(ws + WS_HID); bf16_t* HB = (bf16_t*)(ws + WS_HB);
    bf16_t* WpoS_t = (bf16_t*)(ws + WS_WPOS); bf16_t* Ub = (bf16_t*)(ws + WS_U); bf16_t* APb = (bf16_t*)(ws + WS_AP); bf16_t* MG = (bf16_t*)(ws + WS_MG);
    bf16_t* OG = (bf16_t*)(ws + WS_MG + 2 * MiB);   float* LSE = (float*)(ws + WS_MG + 26 * MiB);
#define IN(k) (lo <= (k) && (k) < hi)
#define REP(k) for (int rep_ = 0; rep_ < ((PROBE_REP == (k)) ? 2 : 1); ++rep_)
#define REP_END(k) do { if (PROBE_REP == (k) && rep_ == 0) GSYNC(); } while (0)
    volatile LAS unsigned* MISC = (volatile LAS unsigned*)(lds + 147456);
    const bool leader = (wave_s == 0) && (__builtin_amdgcn_mbcnt_hi(~0u, __builtin_amdgcn_mbcnt_lo(~0u, 0u)) == 0);
    if (leader) { MISC[8] = 0u; MISC[9] = 0u; }
    __syncthreads();
    XcdBarrier bar; bar.bar = (unsigned*)(ws + WS_BAR); bar.x = xb_xcc_id(); bar.st = MISC + 8;
    if (leader && hi - lo > 1) (void)xb_add(&bar.bar[XB_XCNT(bar.x)], 1u);
#define GSYNC() xcd_barrier(bar, (wave_s == 0) && (__builtin_amdgcn_mbcnt_hi(~0u, __builtin_amdgcn_mbcnt_lo(~0u, 0u)) == 0))
#define SEAM(k) do { if (IN(k) && IN((k) + 1)) GSYNC(); } while (0)

    if (IN(0)) REP(0) {
        FRESH_IDS
        LAS float* scr = (LAS float*)(lds + wave * 16384);
        constexpr int I_IN = (DM / 64) * (NIN / 32), I_ATT = (AM / 64) * (DM / 32), I_GRP = 768 / 8, I_PO = (PW / 64) * (DM / 32), I_OUT = (DM / 64) * (DM / 32),
                      I_1 = (DM / 64) * (FF / 32), I_2 = (FF / 64) * (DM / 32);
        constexpr int NITEMS = I_IN + I_ATT + I_GRP + I_PO + I_OUT + I_1 + I_2;
        for (int it = gw; it < NITEMS; it += NGW) {
            int r = it;
            if (r < I_IN) { const int n0 = 32 * (r % (NIN / 32));
                const int dst = n0 < 3072 ? n0 : (n0 < 4096 ? 3072 + 256 * ((n0 - 3072) >> 7) + ((n0 - 3072) & 127) : 3072 + 256 * ((n0 - 4096) >> 7) + 128 + ((n0 - 4096) & 127));
                transpose_item(args.in[2], NIN, Win_t, DM, dst - n0, 0, nullptr, scr, r, lane); continue; } r -= I_IN;
            if (r < I_ATT) { transpose_item(args.in[3], DM, Wcat_t, DM, 0, 0, nullptr, scr, r, lane); continue; } r -= I_ATT;
            if (r < I_GRP) {
#pragma unroll 1
                for (int rr = 0; rr < 8; ++rr) { const int row = r * 8 + rr, gg = row / 192;
#pragma unroll
                    for (int j = 0; j < 3; ++j) { const int col = j * 256 + lane * 4; u32x2 o = {0u, 0u};
                        if (col / 192 == gg) { const f32x4 wv = *(const f32x4*)(args.in[4] + (size_t)row * 192 + (col - 192 * gg)); o.x = pk2(wv.x, wv.y); o.y = pk2(wv.z, wv.w); }
                        *(u32x2*)(Wgrp_t + (size_t)row * PW + col) = o; } }
                continue; } r -= I_GRP;
            if (r < I_PO) { transpose_item(args.in[6], DM, WpoS_t, PW, 0, 0, args.in[5], scr, r, lane); continue; } r -= I_PO;
            if (r < I_OUT) { transpose_item(args.in[7], DM, Wout_t, DM, 0, 0, nullptr, scr, r, lane); continue; } r -= I_OUT;
            if (r < I_1) { transpose_item(args.in[9], FF, W1_t, DM, 0, 0, args.in[8], scr, r, lane); continue; } r -= I_1;
            if (r < I_2) { transpose_item(args.in[10], DM, W2_t, FF, 0, 0, nullptr, scr, r, lane); continue; } r -= I_2;
        }
        const float* g1 = args.in[1];
        for (int m = gw; m < S; m += 2 * NGW) {
            const int m2 = m + NGW; const bool has2 = m2 < S;
            const f32x4* xr = (const f32x4*)(x + (size_t)m * DM) + lane;
            const f32x4* xr2 = (const f32x4*)(x + (size_t)(has2 ? m2 : m) * DM) + lane;
            f32x4 v[4], v2[4]; float s = 0.f, s2 = 0.f;
#pragma unroll
            for (int j = 0; j < 4; ++j) { v[j] = __builtin_nontemporal_load(&xr[64 * j]); v2[j] = __builtin_nontemporal_load(&xr2[64 * j]); }
#pragma unroll
            for (int j = 0; j < 4; ++j) { s += (v[j].x * v[j].x + v[j].y * v[j].y) + (v[j].z * v[j].z + v[j].w * v[j].w); s2 += (v2[j].x * v2[j].x + v2[j].y * v2[j].y) + (v2[j].z * v2[j].z + v2[j].w * v2[j].w); }
            const float rstd = 1.0f / sqrtf(wave_sum(s) * (1.0f / DM) + EPS), rstd2 = 1.0f / sqrtf(wave_sum(s2) * (1.0f / DM) + EPS);
            unsigned long long* o8 = (unsigned long long*)(Ub + (size_t)m * DM) + lane;
            unsigned long long* o82 = (unsigned long long*)(Ub + (size_t)(has2 ? m2 : m) * DM) + lane;
#pragma unroll
            for (int j = 0; j < 4; ++j) { const f32x4 gv = *((const f32x4*)g1 + lane + 64 * j);
                o8[64 * j] = (unsigned long long)pk2(v[j].x * rstd * gv.x, v[j].y * rstd * gv.y) | ((unsigned long long)pk2(v[j].z * rstd * gv.z, v[j].w * rstd * gv.w) << 32);
                if (has2) o82[64 * j] = (unsigned long long)pk2(v2[j].x * rstd2 * gv.x, v2[j].y * rstd2 * gv.y) | ((unsigned long long)pk2(v2[j].z * rstd2 * gv.z, v2[j].w * rstd2 * gv.w) << 32); }
        }
        for (int i = bx * (NWAVES * 64) + tid; i < S; i += G * NWAVES * 64) { ssq[i] = 0.f; ssq2[i] = 0.f; }
        REP_END(0);
    }
    SEAM(0);

    if (IN(1)) REP(1) {
        pg8::Gemm g{Ub, Win_t}; pg8::StaticOrder So; So.init(S, NIN, G, bx);
        pg8::EpiZ E{Zb};
        pg8::gemm_phase<pg8::EpiZ, pg8::StaticOrder, DM, DM, 0, true>(lds, g, So, E, wave_s);
        REP_END(1);
    }
    SEAM(1);

    if (IN(2)) REP(2) {
        FRESH_IDS
        if ((G & 7) == 0) {
            const int x8 = bx & 7, r8 = bx >> 3, per = G >> 3;
            u32x4 kg[2][4], vg[2][4];
            const int w0 = x8 * 96 + r8, we = x8 * 96 + 96;
            if (w0 < we) attn_stage_load(Zb, w0, wave, lane, kg, vg);
            for (int wu = w0; wu < we; wu += per) attn_wg_unit(Zb, OG, LSE, wu, (wu + per < we) ? wu + per : -1, kg, vg, lds, wave, lane);
        } else {
            u32x4 kg[2][4], vg[2][4];
            if (bx < 768) attn_stage_load(Zb, bx, wave, lane, kg, vg);
            for (int wu = bx; wu < 768; wu += G) attn_wg_unit(Zb, OG, LSE, wu, (wu + G < 768) ? wu + G : -1, kg, vg, lds, wave, lane);
        }
        if ((G & 7) == 0) {
            const int x8 = bx & 7, r8 = bx >> 3, per = (G >> 3) * NWAVES;
            for (int pw = x8 * 768 + r8 * NWAVES + wave; pw < x8 * 768 + 768; pw += per) pool_wave_unit(Zb, APb, pw, lane);
        } else
        for (int pw = gw; pw < 6144; pw += NGW) pool_wave_unit(Zb, APb, pw, lane);
        REP_END(2);
    }
    SEAM(2);

    if (IN(3)) REP(3) {
        FRESH_IDS
        const int mg0 = G > 24 ? 12 : 0;
        for (int e = (bx - mg0) * (NWAVES * 64) + tid; bx >= mg0 && e < S * 32; e += (G - mg0) * NWAVES * 64) {
            const int t = e >> 5, sc = e & 31, slot = sc >> 3;
            const float l0 = LSE[((size_t)0 * S + t) * 4 + slot], l1 = LSE[((size_t)1 * S + t) * 4 + slot], l2 = LSE[((size_t)2 * S + t) * 4 + slot];
            const float mx = fmaxf(l0, fmaxf(l1, l2));
            float w0 = __builtin_amdgcn_exp2f(l0 - mx), w1 = __builtin_amdgcn_exp2f(l1 - mx), w2 = __builtin_amdgcn_exp2f(l2 - mx);
            const float inv = 1.0f / (w0 + w1 + w2); w0 *= inv; w1 *= inv; w2 *= inv;
            const u32x4 a0 = *(const u32x4*)(OG + ((size_t)0 * S + t) * AM + sc * 8), a1 = *(const u32x4*)(OG + ((size_t)1 * S + t) * AM + sc * 8), a2 = *(const u32x4*)(OG + ((size_t)2 * S + t) * AM + sc * 8);
            u32x4 o;
#pragma unroll
            for (int q = 0; q < 4; ++q) o[q] = cvtpk(w0 * bflo(a0[q]) + w1 * bflo(a1[q]) + w2 * bflo(a2[q]), w0 * bfhi(a0[q]) + w1 * bfhi(a1[q]) + w2 * bfhi(a2[q]));
            *(u32x4*)(APb + (size_t)t * DM + sc * 8) = o;
        }
        pg8::Gemm g{WpoS_t, Wgrp_t}; pg8::StaticOrder So; So.init(DM, PW, G, bx);
        pg8::EpiWcomb E{Wcat_t};
        pg8::gemm_phase<pg8::EpiWcomb, pg8::StaticOrder, PW, 384, 192, true>(lds, g, So, E, wave_s);
        REP_END(3);
    }
    SEAM(3);

    if (IN(4)) REP(4) {
        pg8::Gemm g{APb, Wcat_t}; pg8::StaticOrder So; So.init(S, DM, G, bx);
        pg8::EpiMerged E{Zb, MG};
        pg8::gemm_phase<pg8::EpiMerged, pg8::StaticOrder, DM, DM, 0, true>(lds, g, So, E, wave_s);
        REP_END(4);
    }
    SEAM(4);

    if (IN(5)) {
        pg8::Gemm g{MG, Wout_t}; pg8::StaticOrder So; So.init(S, DM, G, bx);
        pg8::EpiWout E{x, HB, ssq, (LAS float*)(lds + pg8::STAGE_BYTES)};
        pg8::gemm_phase<pg8::EpiWout, pg8::StaticOrder, DM, DM, 0, true>(lds, g, So, E, wave_s);
    }
    SEAM(5);

    if (IN(6)) REP(6) {
        pg8::Gemm g{HB, W1_t}; pg8::StaticOrder So; So.init(S, FF, G, bx);
        pg8::EpiUp E{HID, ssq};
        pg8::gemm_phase<pg8::EpiUp, pg8::StaticOrder, DM, DM, 0, true>(lds, g, So, E, wave_s);
        REP_END(6);
    }
    SEAM(6);

    if (IN(7)) {
        pg8::Gemm g{HID, W2_t}; pg8::StaticOrder So; So.init(S, DM, G, bx);
        pg8::EpiDownNorm E{HB, out, ssq2, (unsigned*)(ws + WS_CNT), args.in[11], (LAS float*)(lds + pg8::STAGE_BYTES)};
        pg8::gemm_phase<pg8::EpiDownNorm, pg8::StaticOrder, FF, FF, 0, true>(lds, g, So, E, wave_s);
    }
#undef IN
#undef SEAM
}

#ifndef MK_PER_PHASE
#define MK_PER_PHASE 0
#endif
extern "C" void kernel_launch(void* const* d_in, const int* in_sizes, int n_in, void* d_out, int out_size, void* d_ws, size_t ws_size, hipStream_t stream) {
    static int grid = 0;
    if (grid == 0) {
        if (n_in != 12 || out_size != S * DM || ws_size < WS_END) { fprintf(stderr, "kernel_launch: unexpected shapes (n_in %d out %d ws %zu)\n", n_in, out_size, ws_size); grid = -1; return; }
        int dev = 0, cus = 0, per_cu = 0;
        hipGetDevice(&dev);
        hipDeviceGetAttribute(&cus, hipDeviceAttributeMultiprocessorCount, dev);
        if (hipFuncSetAttribute((const void*)fwd_megakernel, hipFuncAttributeMaxDynamicSharedMemorySize, LDS_BYTES) != hipSuccess) { fprintf(stderr, "kernel_launch: hipFuncSetAttribute failed\n"); grid = -1; return; }
        if (hipOccupancyMaxActiveBlocksPerMultiprocessor(&per_cu, (const void*)fwd_megakernel, NWAVES * 64, LDS_BYTES) != hipSuccess || per_cu < 1) { fprintf(stderr, "kernel_launch: occupancy query gave %d\n", per_cu); per_cu = 1; }
        (void)hipGetLastError();
        grid = cus * (per_cu > 1 ? 1 : per_cu);
        fprintf(stderr, "kernel_launch: grid %d (cus %d, per_cu %d)\n", grid, cus, per_cu);
    }
    if (grid < 0) return;
    Args a{};
    for (int i = 0; i < 12; ++i) a.in[i] = (const float*)d_in[i];
    a.out = (float*)d_out; a.ws = (unsigned char*)d_ws;
#if MK_PER_PHASE
    for (int p = 0; p < NPHASE; ++p) { a.ph_lo = p; a.ph_hi = p + 1; hipLaunchKernelGGL(fwd_megakernel, dim3(grid), dim3(NWAVES * 64), LDS_BYTES, stream, a); }
#else
    a.ph_lo = 0; a.ph_hi = NPHASE;
    if (hipMemsetAsync((char*)d_ws + WS_BAR, 0, BAR_BYTES, stream) != hipSuccess) { fprintf(stderr, "kernel_launch: memset failed\n"); return; }
    void* kargs[] = {&a};
    hipError_t e = hipLaunchCooperativeKernel((void*)fwd_megakernel, dim3(grid), dim3(NWAVES * 64), kargs, LDS_BYTES, stream);
    if (e != hipSuccess) fprintf(stderr, "kernel_launch: cooperative launch failed: %s (grid %d)\n", hipGetErrorString(e), grid);
#endif
}
```

```cpp
#include <hip/hip_runtime.h>
#include <cstdio>
#include <cstdint>

#define LAS __attribute__((address_space(3)))
typedef unsigned short bf16_t;
typedef short bf16x8 __attribute__((ext_vector_type(8)));
typedef float f32x4 __attribute__((ext_vector_type(4)));
typedef float f32x16 __attribute__((ext_vector_type(16)));
typedef unsigned u32x4 __attribute__((ext_vector_type(4)));
typedef unsigned u32x2 __attribute__((ext_vector_type(2)));
typedef short s16x4 __attribute__((ext_vector_type(4)));
typedef float f32x2_t __attribute__((ext_vector_type(2)));
typedef __bf16 bf16x2_t __attribute__((ext_vector_type(2)));

__device__ __forceinline__ unsigned cvtpk(float lo, float hi) { f32x2_t v = {lo, hi}; bf16x2_t b = __builtin_convertvector(v, bf16x2_t); return __builtin_bit_cast(unsigned, b); }
__device__ __forceinline__ float bflo(unsigned v) { return __uint_as_float(v << 16); }
__device__ __forceinline__ float bfhi(unsigned v) { return __uint_as_float(v & 0xffff0000u); }

constexpr int S = 16384, DM = 1024, NIN = 5120, FF = 4096, AM = 256, PW = 768;
constexpr float EPS = 1e-6f;
constexpr float LOG2E = 1.4426950408889634f;
constexpr float C2 = 0.125f * LOG2E;
constexpr int NWAVES = 8;
constexpr int LDS_BYTES = 147456 + 256;

constexpr size_t KiB = 1024, MiB = 1024 * 1024;
constexpr size_t WS_SSQ = 0;
constexpr size_t WS_BAR = 64 * KiB, BAR_BYTES = 32 * KiB;
constexpr size_t WS_CNT = WS_BAR + 16 * KiB;
constexpr size_t WS_SSQ2 = 128 * KiB;
constexpr size_t WS_WIN = 256 * KiB;
constexpr size_t WS_WCAT = WS_WIN + 10 * MiB;
constexpr size_t WS_WGRP = WS_WCAT + 2 * MiB;
constexpr size_t WS_WOUT = WS_WGRP + 1152 * KiB;
constexpr size_t WS_W1 = WS_WOUT + 2 * MiB;
constexpr size_t WS_W2 = WS_W1 + 8 * MiB;
constexpr size_t WS_Z = 32256 * KiB;
constexpr size_t WS_HID = WS_Z;
constexpr size_t WS_HB = WS_Z + 128 * MiB;
constexpr size_t WS_U = WS_Z + 160 * MiB;
constexpr size_t WS_AP = WS_U;
constexpr size_t WS_MG = WS_U + 32 * MiB;
constexpr size_t WS_WPOS = WS_MG;
constexpr size_t WS_END = WS_MG + 32 * MiB;
static_assert(WS_W2 + 8 * MiB <= WS_Z && WS_END <= 256 * MiB, "ws map");
constexpr size_t DO_OG = 0, DO_POOLED = 24 * MiB, DO_LSE = 48 * MiB;

namespace pg8 {
constexpr int BM = 256, BK = 64, HALF = 128, HTB = HALF * BK * 2, STAGE_BYTES = 8 * HTB, NXCD = 8, WGM = 4;
__host__ __device__ __forceinline__ int lds_byte(int r, int c) { const int st = (r >> 4) * 2 + (c >> 5), rr = r & 15, cc = c & 31, ob = rr * 64 + cc * 2; return st * 1024 + (ob ^ (((ob >> 9) & 1) << 5)); }
__host__ __device__ __forceinline__ void stage_rc(int b, int& R, int& C) { const int st = b / 1024, sb = b % 1024, swz = sb ^ (((sb >> 9) & 1) << 5); R = (st >> 1) * 16 + swz / 64; C = (st & 1) * 32 + (swz % 64) / 2; }
__host__ __device__ __forceinline__ int perm32(int rho) { const int n = rho >> 4, i = rho & 15; return 8 * (i >> 2) + 4 * n + (i & 3); }

struct Unit { int pm, pn; };
struct Gemm { const bf16_t* A; const bf16_t* Bt; };

struct StaticOrder {
    int nM, nN, nwg, G, c;
    __host__ __device__ void init(int M, int N, int G_, int c_) { nM = M / BM; nN = N / BM; nwg = nM * nN; G = G_; c = c_; }
    __host__ __device__ bool next(int i, Unit& u) const {
        const long L = (long)i * G + c; if (L >= nwg) return false;
        int wgid = (int)L; { const int q = nwg / NXCD, r = nwg % NXCD, xcd = wgid % NXCD, off = wgid / NXCD; wgid = (xcd < r ? xcd * (q + 1) : r * (q + 1) + (xcd - r) * q) + off; }
        const int nig = WGM * nN, gid = wgid / nig, fm = gid * WGM, gsz = (nM - fm) < WGM ? (nM - fm) : WGM;
        u.pm = fm + ((wgid % nig) % gsz); u.pn = (wgid % nig) / gsz; return true;
    }
};

#define ACC_T const f32x4 (&acc)[2][2][4][2]

struct EpiZ {
    static constexpr bool PERM = true; static constexpr int MID_T = -1;
    bf16_t* Z;
    __device__ __forceinline__ void operator()(ACC_T, const Unit& u, int wr, int wc, int fr, int fq) const {
        const int row0 = u.pm * BM + wr * 64 + fr, col0 = u.pn * BM + wc * 32 + 8 * fq;
        const int mode = u.pn < 3 ? 1 : (u.pn >= 12 ? 2 : 0);
#pragma unroll
        for (int ai = 0; ai < 2; ++ai)
#pragma unroll
            for (int m = 0; m < 4; ++m) { const int row = row0 + ai * HALF + m * 16; bf16_t* rowp = Z + (size_t)row * NIN + col0;
                f32x4 v[2][2];
#pragma unroll
                for (int bj = 0; bj < 2; ++bj) { v[bj][0] = acc[ai][bj][m][0]; v[bj][1] = acc[ai][bj][m][1]; }
                if (mode == 1) {
#pragma unroll
                    for (int bj = 0; bj < 2; ++bj) { v[bj][0] = v[bj][0] * C2; v[bj][1] = v[bj][1] * C2; } }
                if (mode == 2) {
#pragma unroll
                    for (int n = 0; n < 2; ++n)
#pragma unroll
                        for (int e = 0; e < 4; ++e) { const float ea = __builtin_amdgcn_exp2f(-LOG2E * v[0][n][e]), ep = __builtin_amdgcn_exp2f(-LOG2E * v[1][n][e]);
                            const float ia = __builtin_amdgcn_rcpf(1.f + ea), sp = fmaxf(__builtin_amdgcn_rcpf(1.f + ep), 1e-30f);
                            v[0][n][e] = fminf(1.f + ep, 1e30f) * ia; v[1][n][e] = sp; } }
#pragma unroll
                for (int bj = 0; bj < 2; ++bj) { u32x4 w; w.x = cvtpk(v[bj][0][0], v[bj][0][1]); w.y = cvtpk(v[bj][0][2], v[bj][0][3]); w.z = cvtpk(v[bj][1][0], v[bj][1][1]); w.w = cvtpk(v[bj][1][2], v[bj][1][3]);
                    *(u32x4*)(rowp + bj * HALF) = w; } }
    }
};
struct EpiWcomb {
    static constexpr bool PERM = true; static constexpr int MID_T = -1;
    bf16_t* W;
    __device__ __forceinline__ void operator()(ACC_T, const Unit& u, int wr, int wc, int fr, int fq) const {
        const int row0 = u.pm * BM + wr * 64 + fr, col0 = u.pn * BM + wc * 32 + 8 * fq;
#pragma unroll
        for (int ai = 0; ai < 2; ++ai)
#pragma unroll
            for (int m = 0; m < 4; ++m) { bf16_t* rowp = W + (size_t)(row0 + ai * HALF + m * 16) * DM + AM + col0;
#pragma unroll
                for (int bj = 0; bj < 2; ++bj) { const f32x4 v0 = acc[ai][bj][m][0], v1 = acc[ai][bj][m][1];
                    u32x4 w; w.x = cvtpk(v0[0], v0[1]); w.y = cvtpk(v0[2], v0[3]); w.z = cvtpk(v1[0], v1[1]); w.w = cvtpk(v1[2], v1[3]);
                    *(u32x4*)(rowp + bj * HALF) = w; } }
    }
};
struct EpiMerged {
    static constexpr bool PERM = true; static constexpr int MID_T = 4;
    const bf16_t* Z; bf16_t* MG;
    __device__ __forceinline__ void mid(f32x4 (&acc)[2][2][4][2], const Unit& u, int wr, int wc, int fr, int fq) const {
        unsigned off = (unsigned)((u.pm * BM + wr * 64 + fr) * NIN + 3072 + 512 * u.pn + wc * 32 + 8 * fq) * 2u; asm volatile("" : "+v"(off));
        const char* zb = (const char*)Z;
#pragma unroll
        for (int ai = 0; ai < 2; ++ai) {
            u32x4 rt[4][2];
#pragma unroll
            for (int m = 0; m < 4; ++m)
#pragma unroll
                for (int bj = 0; bj < 2; ++bj) rt[m][bj] = *(const u32x4*)(zb + off + (unsigned)((ai * HALF + m * 16) * NIN * 2) + (256 * bj) * 2);
            __builtin_amdgcn_sched_barrier(0);
#pragma unroll
            for (int m = 0; m < 4; ++m)
#pragma unroll
                for (int bj = 0; bj < 2; ++bj)
#pragma unroll
                    for (int q = 0; q < 4; ++q) { acc[ai][bj][m][q >> 1][2 * (q & 1)] *= bflo(rt[m][bj][q]); acc[ai][bj][m][q >> 1][2 * (q & 1) + 1] *= bfhi(rt[m][bj][q]); }
        }
    }
    __device__ __forceinline__ void operator()(ACC_T, const Unit& u, int wr, int wc, int fr, int fq) const {
        const unsigned rc = (unsigned)(u.pm * BM + wr * 64 + fr), cc = (unsigned)(u.pn * BM + wc * 32 + 8 * fq);
        unsigned off = (rc * NIN + 3072 + 128 + 512 * u.pn + wc * 32 + 8 * fq) * 2u, offo = (rc * DM + cc) * 2u; asm volatile("" : "+v"(off), "+v"(offo));
        const char* zb = (const char*)Z; char* ob = (char*)MG;
        u32x4 gpv[2][4][2];
#pragma unroll
        for (int ai = 0; ai < 2; ++ai)
#pragma unroll
            for (int m = 0; m < 4; ++m)
#pragma unroll
                for (int bj = 0; bj < 2; ++bj) gpv[ai][m][bj] = *(const u32x4*)(zb + off + (unsigned)((ai * HALF + m * 16) * NIN * 2) + (256 * bj) * 2);
        __builtin_amdgcn_sched_barrier(0);
#pragma unroll
        for (int ai = 0; ai < 2; ++ai)
#pragma unroll
            for (int m = 0; m < 4; ++m) { const unsigned oo = offo + (unsigned)((ai * HALF + m * 16) * DM * 2);
#pragma unroll
                for (int bj = 0; bj < 2; ++bj) { const u32x4 gp = gpv[ai][m][bj];
                    const f32x4 v0 = acc[ai][bj][m][0], v1 = acc[ai][bj][m][1];
                    u32x4 w; w.x = cvtpk(v0[0] * bflo(gp.x), v0[1] * bfhi(gp.x)); w.y = cvtpk(v0[2] * bflo(gp.y), v0[3] * bfhi(gp.y));
                    w.z = cvtpk(v1[0] * bflo(gp.z), v1[1] * bfhi(gp.z)); w.w = cvtpk(v1[2] * bflo(gp.w), v1[3] * bfhi(gp.w));
                    *(u32x4*)(ob + oo + bj * HALF * 2) = w; } }
    }
};
struct EpiWout {
    static constexpr bool PERM = true; static constexpr int MID_T = -1;
    const float* X; bf16_t* HB; float* ssq; LAS float* red;
    __device__ __forceinline__ void operator()(ACC_T, const Unit& u, int wr, int wc, int fr, int fq) const {
        const int row0 = u.pm * BM + wr * 64 + fr, col0 = u.pn * BM + wc * 32 + 8 * fq;
        float svall[8];
#pragma unroll
        for (int ai = 0; ai < 2; ++ai) {
            f32x4 xa[4][2][2];
#pragma unroll
            for (int m = 0; m < 4; ++m)
#pragma unroll
                for (int bj = 0; bj < 2; ++bj) { const float* xp = X + (size_t)(row0 + ai * HALF + m * 16) * DM + col0 + bj * HALF; xa[m][bj][0] = *(const f32x4*)xp; xa[m][bj][1] = *(const f32x4*)(xp + 4); }
            __builtin_amdgcn_sched_barrier(0);
            float sv[4];
#pragma unroll
            for (int m = 0; m < 4; ++m) { const size_t row = (size_t)(row0 + ai * HALF + m * 16); float s = 0.f;
#pragma unroll
                for (int bj = 0; bj < 2; ++bj) {
                    const f32x4 v0 = xa[m][bj][0] + acc[ai][bj][m][0], v1 = xa[m][bj][1] + acc[ai][bj][m][1];
                    u32x4 w; w.x = cvtpk(v0[0], v0[1]); w.y = cvtpk(v0[2], v0[3]); w.z = cvtpk(v1[0], v1[1]); w.w = cvtpk(v1[2], v1[3]);
                    *(u32x4*)(HB + row * DM + col0 + bj * HALF) = w;
                    s += (v0[0] * v0[0] + v0[1] * v0[1]) + (v0[2] * v0[2] + v0[3] * v0[3]) + (v1[0] * v1[0] + v1[1] * v1[1]) + (v1[2] * v1[2] + v1[3] * v1[3]); }
                s += __shfl_xor(s, 16); s += __shfl_xor(s, 32); sv[m] = s; }
#pragma unroll
            for (int m = 0; m < 4; ++m) svall[ai * 4 + m] = sv[m];
        }
        if (fq == 0) {
#pragma unroll
            for (int i = 0; i < 8; ++i) red[wc * 256 + (i >> 2) * HALF + wr * 64 + (i & 3) * 16 + fr] = svall[i]; }
        asm volatile("s_waitcnt lgkmcnt(0)" ::: "memory"); __builtin_amdgcn_s_barrier(); asm volatile("" ::: "memory");
        const int t = (wr * 4 + wc) * 64 + fq * 16 + fr;
        if (t < 256) __hip_atomic_fetch_add(ssq + (size_t)u.pm * BM + t, (red[t] + red[256 + t]) + (red[512 + t] + red[768 + t]), __ATOMIC_RELAXED, __HIP_MEMORY_SCOPE_AGENT);
    }
};
struct EpiUp {
    static constexpr bool PERM = true; static constexpr int MID_T = -1;
    bf16_t* HID; const float* ssq;
    __device__ __forceinline__ void operator()(ACC_T, const Unit& u, int wr, int wc, int fr, int fq) const {
        const int row0 = u.pm * BM + wr * 64 + fr, col0 = u.pn * BM + wc * 32 + 8 * fq;
#pragma unroll
        for (int ai = 0; ai < 2; ++ai)
#pragma unroll
            for (int m = 0; m < 4; ++m) { const size_t row = (size_t)(row0 + ai * HALF + m * 16);
                const float rs = __builtin_amdgcn_rsqf(ssq[row] * (1.0f / DM) + EPS);
                bf16_t* rowp = HID + row * FF + col0;
#pragma unroll
                for (int bj = 0; bj < 2; ++bj) { f32x4 v0 = acc[ai][bj][m][0] * rs, v1 = acc[ai][bj][m][1] * rs;
#pragma unroll
                    for (int e = 0; e < 4; ++e) { const float a = fmaxf(v0[e], 0.f), b = fmaxf(v1[e], 0.f); v0[e] = a * a; v1[e] = b * b; }
                    u32x4 w; w.x = cvtpk(v0[0], v0[1]); w.y = cvtpk(v0[2], v0[3]); w.z = cvtpk(v1[0], v1[1]); w.w = cvtpk(v1[2], v1[3]);
                    *(u32x4*)(rowp + bj * HALF) = w; } }
    }
};
struct EpiDownNorm {
    static constexpr bool PERM = true; static constexpr int MID_T = -1;
    const bf16_t* HB; float* O; float* ssq2; unsigned* cnt; const float* g3; LAS float* red;
    __device__ __forceinline__ void operator()(f32x4 (&acc)[2][2][4][2], const Unit& u, int wr, int wc, int fr, int fq) const {
        const unsigned rc = (unsigned)(u.pm * BM + wr * 64 + fr), cc = (unsigned)(u.pn * BM + wc * 32 + 8 * fq);
        unsigned offh = (rc * DM + cc) * 2u; asm volatile("" : "+v"(offh));
        const char* hb = (const char*)HB; char* ob = (char*)O;
        {
            u32x4 hv[2][4][2];
#pragma unroll
            for (int ai = 0; ai < 2; ++ai)
#pragma unroll
                for (int m = 0; m < 4; ++m)
#pragma unroll
                    for (int bj = 0; bj < 2; ++bj) hv[ai][m][bj] = *(const u32x4*)(hb + offh + (unsigned)((ai * HALF + m * 16) * DM * 2) + bj * HALF * 2);
            __builtin_amdgcn_sched_barrier(0);
            float sv[8];
#pragma unroll
            for (int ai = 0; ai < 2; ++ai)
#pragma unroll
                for (int m = 0; m < 4; ++m) { float s = 0.f;
#pragma unroll
                    for (int bj = 0; bj < 2; ++bj) { const u32x4 h4 = hv[ai][m][bj];
                        const f32x4 v0 = (f32x4){bflo(h4.x), bfhi(h4.x), bflo(h4.y), bfhi(h4.y)} + acc[ai][bj][m][0], v1 = (f32x4){bflo(h4.z), bfhi(h4.z), bflo(h4.w), bfhi(h4.w)} + acc[ai][bj][m][1];
                        acc[ai][bj][m][0] = v0; acc[ai][bj][m][1] = v1;
                        s += (v0[0] * v0[0] + v0[1] * v0[1]) + (v0[2] * v0[2] + v0[3] * v0[3]) + (v1[0] * v1[0] + v1[1] * v1[1]) + (v1[2] * v1[2] + v1[3] * v1[3]); }
                    s += __shfl_xor(s, 16); s += __shfl_xor(s, 32); sv[ai * 4 + m] = s; }
            if (fq == 0) {
#pragma unroll
                for (int i = 0; i < 8; ++i) red[wc * 256 + (i >> 2) * HALF + wr * 64 + (i & 3) * 16 + fr] = sv[i]; }
            asm volatile("s_waitcnt lgkmcnt(0)" ::: "memory"); __builtin_amdgcn_s_barrier(); asm volatile("" ::: "memory");
            if (wr == 0 && wc == 0) { const int l64 = fq * 16 + fr;
#pragma unroll
                for (int q = 0; q < 4; ++q) { const int t = q * 64 + l64;
                    __hip_atomic_fetch_add(ssq2 + (size_t)u.pm * BM + t, (red[t] + red[256 + t]) + (red[512 + t] + red[768 + t]), __ATOMIC_RELAXED, __HIP_MEMORY_SCOPE_AGENT); }
                asm volatile("s_waitcnt vmcnt(0)" ::: "memory"); }
        }
        unsigned* pc = cnt + 64 * u.pm;
        f32x4 gv[2][2];
#pragma unroll
        for (int bj = 0; bj < 2; ++bj) { gv[bj][0] = *(const f32x4*)(g3 + cc + bj * HALF); gv[bj][1] = *(const f32x4*)(g3 + cc + bj * HALF + 4); }
        if (wr == 0 && wc == 0) {
            if (fr == 0 && fq == 0) __hip_atomic_fetch_add(pc, 1u, __ATOMIC_RELAXED, __HIP_MEMORY_SCOPE_AGENT);
            unsigned sp = 0u;
            while (__hip_atomic_load(pc, __ATOMIC_RELAXED, __HIP_MEMORY_SCOPE_AGENT) < 4u) { __builtin_amdgcn_s_sleep(2); if (++sp > (1u << 20)) break; }
        }
        asm volatile("s_waitcnt vmcnt(0) lgkmcnt(0)" ::: "memory"); __builtin_amdgcn_s_barrier(); asm volatile("" ::: "memory");
        float rsv[8];
#pragma unroll
        for (int i = 0; i < 8; ++i) rsv[i] = __hip_atomic_load(ssq2 + rc + ((i >> 2) * HALF + (i & 3) * 16), __ATOMIC_RELAXED, __HIP_MEMORY_SCOPE_AGENT);
        __builtin_amdgcn_sched_barrier(0);
#pragma unroll
        for (int ai = 0; ai < 2; ++ai)
#pragma unroll
            for (int m = 0; m < 4; ++m) { const unsigned ro = offh + (unsigned)((ai * HALF + m * 16) * DM * 2);
                const float rs = __builtin_amdgcn_rsqf(rsv[ai * 4 + m] * (1.0f / DM) + EPS);
#pragma unroll
                for (int bj = 0; bj < 2; ++bj) { const f32x4 v0 = acc[ai][bj][m][0], v1 = acc[ai][bj][m][1];
                    float* op = (float*)(ob + 2 * ro + bj * HALF * 4);
                    *(f32x4*)op = v0 * rs * gv[bj][0]; *(f32x4*)(op + 4) = v1 * rs * gv[bj][1]; } }
    }
};

template <class Epi, class Sched, int K, int KLOOP, int KOFF, bool ALIGN_EPI = true>
__device__ __forceinline__ void gemm_phase(LAS unsigned char* lds, const Gemm g, const Sched& Sc, const Epi& E, const int wid) {
    int lane = __builtin_amdgcn_mbcnt_hi(~0u, __builtin_amdgcn_mbcnt_lo(~0u, 0u)); asm volatile("" : "+v"(lane));
    const int tid = wid * 64 + lane, wr = wid >> 2, wc = wid & 3, fr = lane & 15, fq = lane >> 4;
    constexpr int nt = KLOOP / BK;
    unsigned voffA[2], voffB[2];
#pragma unroll
    for (int i = 0; i < 2; ++i) { int R, C; stage_rc(tid * 16 + i * 8192, R, C); const int Rb = Epi::PERM ? ((R & ~31) + perm32(R & 31)) : R;
        voffA[i] = (unsigned)(R * K + C) * 2u; voffB[i] = (unsigned)(Rb * K + C) * 2u; }
    constexpr size_t kstep = (size_t)(BK * 2);
    constexpr size_t hstep = (size_t)HALF * K * 2;
    constexpr size_t tstep = 2 * hstep;
    constexpr size_t kofs = (size_t)KOFF * 2;
    const unsigned ldsw = (unsigned)wid * 1024u;
    const int aoff = lds_byte(wr * 64 + fr, fq * 8), boff = lds_byte(wc * 32 + fr, fq * 8);
#define PG8_SA(b, h) (((b) * 2 + (h)) * HTB)
#define PG8_SB(b, h) ((4 + (b) * 2 + (h)) * HTB)
#define PG8_STAGE(bufoff, gbase, voff) do { _Pragma("unroll") for (int _i = 0; _i < 2; ++_i) \
        __builtin_amdgcn_global_load_lds((const unsigned*)((const char*)(gbase) + (voff)[_i]), (LAS unsigned*)(lds + (bufoff) + ldsw + _i * 8192), 16, 0, 0); } while (0)
#define PG8_LDA(dst, b, h) do { _Pragma("unroll") for (int m = 0; m < 4; ++m) _Pragma("unroll") for (int k = 0; k < 2; ++k) dst[m][k] = *(const LAS bf16x8*)(lds + PG8_SA(b, h) + aoff + m * 2048 + k * 1024); } while (0)
#define PG8_LDB(dst, b, h) do { _Pragma("unroll") for (int n = 0; n < 2; ++n) _Pragma("unroll") for (int k = 0; k < 2; ++k) dst[n][k] = *(const LAS bf16x8*)(lds + PG8_SB(b, h) + boff + n * 2048 + k * 1024); } while (0)
#define PG8_MMA(ai, bj, At, Bt) do { __builtin_amdgcn_s_setprio(1); _Pragma("unroll") for (int m = 0; m < 4; ++m) _Pragma("unroll") for (int n = 0; n < 2; ++n) _Pragma("unroll") for (int k = 0; k < 2; ++k) \
        acc[ai][bj][m][n] = __builtin_amdgcn_mfma_f32_16x16x32_bf16(Bt[n][k], At[m][k], acc[ai][bj][m][n], 0, 0, 0); __builtin_amdgcn_s_setprio(0); } while (0)
#define PG8_WAIT_V(n) asm volatile("s_waitcnt vmcnt(" #n ")" ::: "memory")
#define PG8_WAIT_L(n) asm volatile("s_waitcnt lgkmcnt(" #n ")" ::: "memory")
#define PG8_BAR __builtin_amdgcn_s_barrier()
#define PG8_SCHED __builtin_amdgcn_sched_barrier(0)
    Unit cur, nxt; int ui = 0;
    if (!Sc.next(0, cur)) return;
    f32x4 acc[2][2][4][2];
#pragma unroll
    for (int a = 0; a < 2; ++a)
#pragma unroll
        for (int b = 0; b < 2; ++b)
#pragma unroll
            for (int m = 0; m < 4; ++m)
#pragma unroll
                for (int n = 0; n < 2; ++n) acc[a][b][m][n] = (f32x4){0.f, 0.f, 0.f, 0.f};
    bf16x8 At[4][2], B0[2][2], B1[2][2];
    const char* cA = (const char*)g.A + (size_t)cur.pm * tstep + (size_t)cur.pn * kofs; const char* cB = (const char*)g.Bt + (size_t)cur.pn * tstep + (size_t)cur.pn * kofs;
    PG8_STAGE(PG8_SB(0, 0), cB, voffB); PG8_STAGE(PG8_SB(0, 1), cB + hstep, voffB); PG8_STAGE(PG8_SA(0, 0), cA, voffA); PG8_STAGE(PG8_SA(0, 1), cA + hstep, voffA);
    if (wr == 1) PG8_BAR;
    PG8_WAIT_V(2); PG8_BAR;
    PG8_STAGE(PG8_SB(1, 0), cB + kstep, voffB); PG8_STAGE(PG8_SA(1, 0), cA + kstep, voffA); PG8_STAGE(PG8_SB(1, 1), cB + hstep + kstep, voffB);
    PG8_WAIT_V(6); PG8_BAR;
    for (;;) {
        const bool has_next = Sc.next(ui + 1, nxt);
        const char* nA = has_next ? (const char*)g.A + (size_t)nxt.pm * tstep + (size_t)nxt.pn * kofs : cA; const char* nB = has_next ? (const char*)g.Bt + (size_t)nxt.pn * tstep + (size_t)nxt.pn * kofs : cB;
#pragma unroll 1
        for (int t = 0; t < nt; t += 2) {
            const bool last = (t == nt - 2);
            const char* a1 = cA + (size_t)(t + 1) * kstep;
            const char* a2 = last ? nA : cA + (size_t)(t + 2) * kstep; const char* b2 = last ? nB : cB + (size_t)(t + 2) * kstep;
            const char* a3 = a2 + kstep; const char* b3 = b2 + kstep;
            if constexpr (Epi::MID_T > 0) { if (t == Epi::MID_T) E.mid(acc, cur, wr, wc, fr, fq); }
            PG8_LDB(B0, 0, 0); PG8_LDB(B1, 0, 1); PG8_SCHED; PG8_LDA(At, 0, 0); PG8_STAGE(PG8_SA(1, 1), a1 + hstep, voffA);
            PG8_WAIT_V(8); PG8_WAIT_L(0); PG8_BAR; PG8_MMA(0, 0, At, B0); PG8_MMA(0, 1, At, B1); PG8_BAR; PG8_SCHED;
            PG8_LDA(At, 0, 1); PG8_STAGE(PG8_SB(0, 0), b2, voffB); PG8_STAGE(PG8_SB(0, 1), b2 + hstep, voffB); PG8_STAGE(PG8_SA(0, 0), a2, voffA);
            PG8_WAIT_V(8); PG8_WAIT_L(0); PG8_BAR; PG8_MMA(1, 0, At, B0); PG8_MMA(1, 1, At, B1); PG8_BAR; PG8_SCHED;
            PG8_LDB(B0, 1, 0); PG8_LDB(B1, 1, 1); PG8_SCHED; PG8_LDA(At, 1, 0); PG8_STAGE(PG8_SA(0, 1), a2 + hstep, voffA);
            PG8_WAIT_V(8); PG8_WAIT_L(0); PG8_BAR; PG8_MMA(0, 0, At, B0); PG8_MMA(0, 1, At, B1); PG8_BAR; PG8_SCHED;
            PG8_LDA(At, 1, 1); PG8_STAGE(PG8_SB(1, 0), b3, voffB); PG8_STAGE(PG8_SB(1, 1), b3 + hstep, voffB); PG8_STAGE(PG8_SA(1, 0), a3, voffA);
            PG8_WAIT_V(8); PG8_WAIT_L(0); PG8_BAR; PG8_MMA(1, 0, At, B0); PG8_MMA(1, 1, At, B1); PG8_BAR; PG8_SCHED;
        }
        if constexpr (ALIGN_EPI) { if (wr == 0) PG8_BAR; }
        E(acc, cur, wr, wc, fr, fq);
        if (!has_next) break;
#pragma unroll
        for (int a = 0; a < 2; ++a)
#pragma unroll
            for (int b = 0; b < 2; ++b)
#pragma unroll
                for (int m = 0; m < 4; ++m)
#pragma unroll
                    for (int n = 0; n < 2; ++n) acc[a][b][m][n] = (f32x4){0.f, 0.f, 0.f, 0.f};
        cur = nxt; cA = nA; cB = nB; ++ui;
        if constexpr (ALIGN_EPI) { if (wr == 1) PG8_BAR; }
    }
    PG8_WAIT_V(0);
    if constexpr (!ALIGN_EPI) { if (wr == 0) PG8_BAR; }
    PG8_BAR;
#undef PG8_SA
#undef PG8_SB
#undef PG8_STAGE
#undef PG8_LDA
#undef PG8_LDB
#undef PG8_MMA
#undef PG8_WAIT_V
#undef PG8_WAIT_L
#undef PG8_BAR
#undef PG8_SCHED
}
}

__device__ __forceinline__ unsigned f2bf(float f) { unsigned u = __builtin_bit_cast(unsigned, f); return (u + 0x7fffu + ((u >> 16) & 1u)) >> 16; }
__device__ __forceinline__ unsigned pk2(float lo, float hi) { return f2bf(lo) | (f2bf(hi) << 16); }
__device__ __forceinline__ float wave_sum(float v) {
#pragma unroll
    for (int o = 1; o < 64; o <<= 1) v += __shfl_xor(v, o);
    return v;
}
__device__ __forceinline__ void transpose_item(const float* W, int N, bf16_t* WT, int ldt, int row_off, int col_off, const float* kscale, LAS float* scr, int item, int lane) {
    const int nblk = N / 32, kb = item / nblk, nb = item % nblk, k0 = 64 * kb, n0 = 32 * nb;
    float tv[32];
#pragma unroll
    for (int i = 0; i < 32; ++i) { const int kk = 2 * i + (lane >> 5); tv[i] = __builtin_nontemporal_load(&W[(size_t)(k0 + kk) * N + n0 + (lane & 31)]); }
    if (kscale) {
#pragma unroll
        for (int i = 0; i < 32; ++i) tv[i] *= kscale[k0 + 2 * i + (lane >> 5)]; }
#pragma unroll
    for (int i = 0; i < 32; ++i) scr[(2 * i + (lane >> 5)) * 33 + (lane & 31)] = tv[i];
    asm volatile("s_waitcnt lgkmcnt(0)" ::: "memory");
    const int c = lane & 7;
#pragma unroll
    for (int j = 0; j < 4; ++j) { const int n = (lane >> 3) + 8 * j; const LAS float* s = scr + (8 * c) * 33 + n;
        u32x4 o; o.x = pk2(s[0 * 33], s[1 * 33]); o.y = pk2(s[2 * 33], s[3 * 33]); o.z = pk2(s[4 * 33], s[5 * 33]); o.w = pk2(s[6 * 33], s[7 * 33]);
        *(u32x4*)(WT + (size_t)(row_off + n0 + n) * ldt + col_off + k0 + 8 * c) = o; }
    asm volatile("s_waitcnt lgkmcnt(0)" ::: "memory");
}

__device__ __forceinline__ int crow(int r, int hi) { return (r & 3) + 8 * (r >> 2) + 4 * hi; }
#define MFMA32(a, b, c) __builtin_amdgcn_mfma_f32_32x32x16_bf16((a), (b), (c), 0, 0, 0)
constexpr int VROW = 144;

constexpr int KIMG_OFF = 0, VIMG_OFF = 384 * VROW, OSTG_OFF = 2 * 384 * VROW;
__device__ __forceinline__ void attn_stage_load(const bf16_t* __restrict__ Z, int wu, int wave, int lane, u32x4 (&kg)[2][4], u32x4 (&vg)[2][4]) {
    const int g = wu >> 8, rem = wu & 255;
    const int dsh = 2 * g, d = 1 << dsh, nwsh = 6 - dsh;
    const int qbw = rem & ((1 << nwsh) - 1), hr = rem >> nwsh;
    const int r = hr & (d - 1), hh = hr >> dsh, h = g * 4 + hh;
    const int i0wg = qbw * 256;
    const char* Zc = (const char*)Z;
    const int vstep = (8 * d) * (NIN * 2);
#pragma unroll
    for (int jj = 0; jj < 2; ++jj) { const int j = wave + 8 * jj;
        if (j < 12 && i0wg - 128 + 32 * j >= 0) {
            const unsigned off = (unsigned)(((i0wg - 128 + 32 * j + (lane >> 3)) * d + r) * (NIN * 2) + (768 + h * 64 + (lane & 7) * 8) * 2);
#pragma unroll
            for (int i = 0; i < 4; ++i) { kg[jj][i] = *(const u32x4*)(Zc + off + i * vstep); vg[jj][i] = *(const u32x4*)(Zc + off + 1536 + i * vstep); } } }
}
__device__ __forceinline__ void attn_wg_unit(const bf16_t* __restrict__ Z, bf16_t* __restrict__ OG, float* __restrict__ LSE, int wu, int wu_next, u32x4 (&kg)[2][4], u32x4 (&vg)[2][4], LAS unsigned char* lds, int wave, int lane) {
    const int g = wu >> 8, rem = wu & 255;
    const int dsh = 2 * g, d = 1 << dsh, nwsh = 6 - dsh;
    const int qbw = rem & ((1 << nwsh) - 1), hr = rem >> nwsh;
    const int r = hr & (d - 1), hh = hr >> dsh, h = g * 4 + hh;
    const int ql = lane & 31, hi = lane >> 5;
    const int i0wg = qbw * 256, i0 = i0wg + 32 * wave;
    const float slope2 = exp2f(-8.0f * (float)(h + 1) / 12.0f) * LOG2E * (float)d;
    const char* Zc = (const char*)Z;
    LAS unsigned char* kimg = lds + KIMG_OFF; LAS unsigned char* vimg = lds + VIMG_OFF; LAS unsigned char* ostg = lds + OSTG_OFF + wave * (32 * VROW);
#pragma unroll
    for (int jj = 0; jj < 2; ++jj) { const int j = wave + 8 * jj;
        if (j < 12 && i0wg - 128 + 32 * j >= 0) {
            const int ro = (32 * j + (lane >> 3)) * VROW + (lane & 7) * 16;
#pragma unroll
            for (int i = 0; i < 4; ++i) { *(LAS u32x4*)(kimg + ro + 8 * i * VROW) = kg[jj][i]; *(LAS u32x4*)(vimg + ro + 8 * i * VROW) = vg[jj][i]; } } }
    const unsigned tq = (unsigned)((i0 + ql) * d + r);
    bf16x8 qf[4];
    { const char* qp = Zc + tq * (unsigned)(NIN * 2) + (unsigned)((h * 64 + hi * 8) * 2);
#pragma unroll
      for (int d0 = 0; d0 < 4; ++d0) qf[d0] = *(const bf16x8*)(qp + d0 * 32); }
    const int kt0 = i0 >= 128 ? 0 : ((128 - i0) >> 5);
    f32x16 cb, cb0, cb4;
#pragma unroll
    for (int i = 0; i < 16; ++i) { const int ci = (i & 3) + 8 * (i >> 2) + 4 * hi; const float bv = -slope2 * (float)(128 + ql - ci);
        cb[i] = bv; cb0[i] = (ci >= ql) ? bv : -1e30f; cb4[i] = (ci <= ql) ? bv : -1e30f; }
    asm volatile("s_waitcnt lgkmcnt(0)" ::: "memory"); __builtin_amdgcn_s_barrier(); asm volatile("" ::: "memory");
    if (wu_next >= 0) attn_stage_load(Z, wu_next, wave, lane, kg, vg);
    const LAS unsigned char* kr = kimg + (32 * wave + ql) * VROW + hi * 16;
    const LAS unsigned char* vr = vimg + (32 * wave) * VROW + ((lane >> 4) & 1) * 32 + (lane & 3) * 8 + (((lane & 15) >> 2) + 4 * hi) * VROW;
    f32x16 sc[5];
#pragma unroll
    for (int kt = 0; kt < 5; ++kt) {
        if (kt >= kt0) {
            f32x16 s = (kt == 0) ? cb0 : ((kt == 4) ? cb4 : cb);
#pragma unroll
            for (int d0 = 0; d0 < 4; ++d0) { const bf16x8 kf = *(const LAS bf16x8*)(kr + kt * 32 * VROW + d0 * 32); s = MFMA32(kf, qf[d0], s); }
            sc[kt] = s;
        } else {
#pragma unroll
            for (int i = 0; i < 16; ++i) sc[kt][i] = -1e30f;
        }
    }
    float mrow = -1e30f;
#pragma unroll
    for (int kt = 0; kt < 5; ++kt) { float mt = sc[kt][0];
#pragma unroll
        for (int i = 1; i < 16; ++i) mt = fmaxf(mt, sc[kt][i]);
        mrow = fmaxf(mrow, mt + (float)(32 * kt) * slope2); }
    mrow = fmaxf(mrow, __shfl_xor(mrow, 32));
    f32x16 oT[2];
#pragma unroll
    for (int i = 0; i < 16; ++i) { oT[0][i] = 0.f; oT[1][i] = 0.f; }
    float lrun = 0.f;
#pragma unroll
    for (int kt = 0; kt < 5; ++kt) {
        if (kt >= kt0) {
            const float sh = (float)(32 * kt) * slope2 - mrow;
            float ls = 0.f;
#pragma unroll
            for (int i = 0; i < 16; ++i) { const float pe = __builtin_amdgcn_exp2f(sc[kt][i] + sh); sc[kt][i] = pe; ls += pe; }
            lrun += ls;
#pragma unroll
            for (int j = 0; j < 2; ++j) {
                u32x4 pw; pw.x = cvtpk(sc[kt][8 * j + 0], sc[kt][8 * j + 1]); pw.y = cvtpk(sc[kt][8 * j + 2], sc[kt][8 * j + 3]); pw.z = cvtpk(sc[kt][8 * j + 4], sc[kt][8 * j + 5]); pw.w = cvtpk(sc[kt][8 * j + 6], sc[kt][8 * j + 7]);
                const bf16x8 pb = __builtin_bit_cast(bf16x8, pw);
#pragma unroll
                for (int dt = 0; dt < 2; ++dt) {
                    const s16x4 lo = __builtin_bit_cast(s16x4, __builtin_amdgcn_ds_read_tr16_b64_v4i16((LAS s16x4*)(vr + (32 * kt + 16 * j) * VROW + dt * 64)));
                    const s16x4 hv = __builtin_bit_cast(s16x4, __builtin_amdgcn_ds_read_tr16_b64_v4i16((LAS s16x4*)(vr + (32 * kt + 16 * j + 8) * VROW + dt * 64)));
                    const bf16x8 va = {lo[0], lo[1], lo[2], lo[3], hv[0], hv[1], hv[2], hv[3]};
                    oT[dt] = MFMA32(va, pb, oT[dt]);
                }
            }
        }
    }
    const float ltot = lrun + __shfl_xor(lrun, 32);
    const float inv = __builtin_amdgcn_rcpf(ltot);
#pragma unroll
    for (int dt = 0; dt < 2; ++dt)
#pragma unroll
        for (int rq = 0; rq < 4; ++rq) {
            u32x2 wv; wv.x = cvtpk(oT[dt][4 * rq] * inv, oT[dt][4 * rq + 1] * inv); wv.y = cvtpk(oT[dt][4 * rq + 2] * inv, oT[dt][4 * rq + 3] * inv);
            *(LAS u32x2*)(ostg + ql * VROW + (32 * dt + 8 * rq + 4 * hi) * 2) = wv;
        }
    asm volatile("s_waitcnt lgkmcnt(0)" ::: "memory");
#pragma unroll
    for (int i = 0; i < 4; ++i) { const int row = (lane >> 3) + 8 * i;
        const u32x4 ov = *(const LAS u32x4*)(ostg + row * VROW + (lane & 7) * 16);
        *(u32x4*)(OG + ((size_t)g * S + (size_t)((i0 + row) * d + r)) * AM + hh * 64 + (lane & 7) * 8) = ov; }
    if (hi == 0) LSE[((size_t)g * S + tq) * 4 + hh] = mrow + log2f(ltot);
    asm volatile("s_waitcnt lgkmcnt(0)" ::: "memory"); __builtin_amdgcn_s_barrier(); asm volatile("" ::: "memory");
}

__device__ __forceinline__ void pool_half(const unsigned (&v)[31], const bool hi_half, const int wsel, float (&o)[16]) {
    float a[31];
#pragma unroll
    for (int j = 0; j < 31; ++j) a[j] = hi_half ? bfhi(v[j]) : bflo(v[j]);
#pragma unroll
    for (int j = 30; j >= 1; --j) a[j] += a[j - 1];
#pragma unroll
    for (int i = 0; i < 16; ++i) o[i] = a[15 + i];
#pragma unroll
    for (int j = 30; j >= 3; --j) a[j] += a[j - 2];
#pragma unroll
    for (int i = 0; i < 16; ++i) o[i] = (wsel >= 1) ? a[15 + i] : o[i];
#pragma unroll
    for (int j = 30; j >= 7; --j) a[j] += a[j - 4];
#pragma unroll
    for (int i = 0; i < 16; ++i) o[i] = (wsel >= 2) ? a[15 + i] : o[i];
#pragma unroll
    for (int j = 30; j >= 15; --j) a[j] += a[j - 8];
#pragma unroll
    for (int i = 0; i < 16; ++i) o[i] = (wsel >= 3) ? a[15 + i] : o[i];
}
__device__ __forceinline__ void pool_wave_unit(const bf16_t* __restrict__ Z, bf16_t* __restrict__ PO, int pw, int lane) {
    const int cb = pw % 6, c = pw / 6;
    const int col = cb * 128 + 2 * lane;
    const int wsel = col / 192, w = 2 << wsel;
    const int t0 = c * 16;
    const bf16_t* src = Z + 2304 + col;
    unsigned v[31];
#pragma unroll
    for (int j = 0; j < 31; ++j) { const int t = t0 - 15 + j; v[j] = (t >= 0) ? *(const unsigned*)(src + (size_t)t * NIN) : 0u; }
    float o0[16], o1[16];
    pool_half(v, false, wsel, o0);
    pool_half(v, true, wsel, o1);
    const float invw = 1.0f / (float)w;
#pragma unroll
    for (int i = 0; i < 16; ++i) {
        const int t = t0 + i;
        float inv = invw;
        if (t0 == 0) { const int cnt = (t + 1) < w ? (t + 1) : w; inv = 1.0f / (float)cnt; }
        *(unsigned*)(PO + (size_t)t * DM + AM + col) = cvtpk(o0[i] * inv - bflo(v[15 + i]), o1[i] * inv - bfhi(v[15 + i]));
    }
}

#define XB_TMO      128
#define XB_XCNT(j)  (256  + 64 * (j))
#define XB_XSUB(j)  (1280 + 64 * (j))
#define XB_XGEN(j)  (2304 + 64 * (j))
#define XB_TOP      3328
#define XB_TOPGEN   3392
#define XCD_BAR_WORDS 3456
#define XB_SPIN_CAP (1u << 18)
__device__ __forceinline__ unsigned xb_ld(unsigned* p)              { return __hip_atomic_load(p, __ATOMIC_RELAXED, __HIP_MEMORY_SCOPE_AGENT); }
__device__ __forceinline__ unsigned xb_add(unsigned* p, unsigned v) { return __hip_atomic_fetch_add(p, v, __ATOMIC_RELAXED, __HIP_MEMORY_SCOPE_AGENT); }
__device__ __forceinline__ unsigned xb_xcc_id() { return (unsigned)__builtin_amdgcn_s_getreg((3 << 11) | 20) & 0xFu; }
#define XB_SPIN(cond, bar) do { unsigned _sp = 0; while (cond) { __builtin_amdgcn_s_sleep(1); \
    if ((++_sp & 255u) == 0u) { if (xb_ld(&(bar)[XB_TMO])) break; if (_sp > XB_SPIN_CAP) { atomicAdd(&(bar)[XB_TMO], 1u); break; } } } } while (0)
struct XcdBarrier { unsigned* bar; unsigned x; volatile LAS unsigned* st; };
__device__ __forceinline__ void xcd_barrier_complete(unsigned* bar, unsigned x, unsigned& nloc, unsigned& nx) {
    const unsigned G = gridDim.x * gridDim.y * gridDim.z;
    unsigned sum, cnt, mine, sp = 0u;
    for (;;) {
        sum = 0u; cnt = 0u; mine = 0u;
#pragma unroll
        for (unsigned j = 0; j < 16; ++j) { const unsigned c = xb_ld(&bar[XB_XCNT(j)]); sum += c; cnt += (c > 0u) ? 1u : 0u; mine = (j == x) ? c : mine; }
        if (sum == G) break;
        __builtin_amdgcn_s_sleep(1);
        if ((++sp & 255u) == 0u) { if (xb_ld(&bar[XB_TMO])) break; if (sp > XB_SPIN_CAP) { atomicAdd(&bar[XB_TMO], 1u); break; } }
    }
    nloc = mine > 0u ? mine : 1u; nx = cnt > 0u ? cnt : 1u;
}
__device__ __forceinline__ void xcd_barrier(const XcdBarrier& b, const bool leader) {
    asm volatile("s_waitcnt vmcnt(0)" ::: "memory");
    __syncthreads();
    if (leader) {
        unsigned* bar = b.bar;
        __builtin_amdgcn_s_waitcnt(0);
        __builtin_amdgcn_fence(__ATOMIC_ACQUIRE, "agent");
        unsigned nloc = b.st[0], nx = b.st[1];
        if (nloc == 0u) { xcd_barrier_complete(bar, b.x, nloc, nx); b.st[0] = nloc; b.st[1] = nx; }
        const unsigned old = xb_add(&bar[XB_XSUB(b.x)], 1u);
        const unsigned gen = old / nloc;
        if (old + 1u == (gen + 1u) * nloc) {
            __builtin_amdgcn_fence(__ATOMIC_RELEASE, "agent");
            asm volatile("s_waitcnt vmcnt(0)" ::: "memory");
            const unsigned og = xb_add(&bar[XB_TOP], 1u);
            const unsigned tg = og / nx;
            if (og + 1u == (tg + 1u) * nx) xb_add(&bar[XB_TOPGEN], 1u);
            else XB_SPIN(xb_ld(&bar[XB_TOPGEN]) == tg, bar);
            asm volatile("s_waitcnt vmcnt(0)" ::: "memory");
        } else {
            XB_SPIN(xb_ld(&bar[XB_TOPGEN]) == gen, bar);
            asm volatile("s_waitcnt vmcnt(0)" ::: "memory");
        }
    }
    __syncthreads();
}

#ifndef PROBE_REP
#define PROBE_REP -1
#endif
#ifndef PROBE_SYNCS
#define PROBE_SYNCS 0
#endif
struct Args { const float* in[12]; float* out; unsigned char* ws; int ph_lo, ph_hi; };
constexpr int NPHASE = 8;

__global__ void __launch_bounds__(NWAVES * 64, 2) fwd_megakernel(Args args) {
    extern __shared__ __attribute__((aligned(16))) unsigned char lds_raw[];
    LAS unsigned char* lds = (LAS unsigned char*)lds_raw;
    const int G = gridDim.x, bx = blockIdx.x;
    const int NGW = G * NWAVES;
    const int wave_s = __builtin_amdgcn_readfirstlane((int)threadIdx.x >> 6);
#define FRESH_IDS int lane = __builtin_amdgcn_mbcnt_hi(~0u, __builtin_amdgcn_mbcnt_lo(~0u, 0u)); asm volatile("" : "+v"(lane)); const int wave = wave_s, tid = wave * 64 + lane; const int gw = bx * NWAVES + wave; (void)gw; (void)tid;
    const int lo = args.ph_lo, hi = args.ph_hi;
    unsigned char* ws = args.ws;
    const float* x = args.in[0];
    float* out = args.out;
    float* ssq = (float*)(ws + WS_SSQ); float* ssq2 = (float*)(ws + WS_SSQ2);
    bf16_t* Win_t = (bf16_t*)(ws + WS_WIN); bf16_t* Wcat_t = (bf16_t*)(ws + WS_WCAT); bf16_t* Wgrp_t = (bf16_t*)(ws + WS_WGRP);
    bf16_t* Wout_t = (bf16_t*)(ws + WS_WOUT); bf16_t* W1_t = (bf16_t*)(ws + WS_W1); bf16_t* W2_t = (bf16_t*)(ws + WS_W2);
    bf16_t* Zb = (bf16_t*)(ws + WS_Z); bf16_t* HID = (bf16_t*)(ws + WS_HID); bf16_t* HB = (bf16_t*)(ws + WS_HB);
    bf16_t* WpoS_t = (bf16_t*)(ws + WS_WPOS); bf16_t* Ub = (bf16_t*)(ws + WS_U); bf16_t* APb = (bf16_t*)(ws + WS_AP); bf16_t* MG = (bf16_t*)(ws + WS_MG);
    bf16_t* OG = (bf16_t*)(ws + WS_MG + 2 * MiB);   float* LSE = (float*)(ws + WS_MG + 26 * MiB);
#define IN(k) (lo <= (k) && (k) < hi)
#define REP(k) for (int rep_ = 0; rep_ < ((PROBE_REP == (k)) ? 2 : 1); ++rep_)
#define REP_END(k) do { if (PROBE_REP == (k) && rep_ == 0) GSYNC(); } while (0)
    volatile LAS unsigned* MISC = (volatile LAS unsigned*)(lds + 147456);
    const bool leader = (wave_s == 0) && (__builtin_amdgcn_mbcnt_hi(~0u, __builtin_amdgcn_mbcnt_lo(~0u, 0u)) == 0);
    if (leader) { MISC[8] = 0u; MISC[9] = 0u; }
    __syncthreads();
    XcdBarrier bar; bar.bar = (unsigned*)(ws + WS_BAR); bar.x = xb_xcc_id(); bar.st = MISC + 8;
    if (leader && hi - lo > 1) (void)xb_add(&bar.bar[XB_XCNT(bar.x)], 1u);
#define GSYNC() xcd_barrier(bar, (wave_s == 0) && (__builtin_amdgcn_mbcnt_hi(~0u, __builtin_amdgcn_mbcnt_lo(~0u, 0u)) == 0))
#define SEAM(k) do { if (IN(k) && IN((k) + 1)) GSYNC(); } while (0)

    if (IN(0)) REP(0) {
        FRESH_IDS
        LAS float* scr = (LAS float*)(lds + wave * 16384);
        constexpr int I_IN = (DM / 64) * (NIN / 32), I_ATT = (AM / 64) * (DM / 32), I_GRP = 768 / 8, I_PO = (PW / 64) * (DM / 32), I_OUT = (DM / 64) * (DM / 32),
                      I_1 = (DM / 64) * (FF / 32), I_2 = (FF / 64) * (DM / 32);
        constexpr int NITEMS = I_IN + I_ATT + I_GRP + I_PO + I_OUT + I_1 + I_2;
        for (int it = gw; it < NITEMS; it += NGW) {
            int r = it;
            if (r < I_IN) { const int n0 = 32 * (r % (NIN / 32));
                const int dst = n0 < 3072 ? n0 : (n0 < 4096 ? 3072 + 256 * ((n0 - 3072) >> 7) + ((n0 - 3072) & 127) : 3072 + 256 * ((n0 - 4096) >> 7) + 128 + ((n0 - 4096) & 127));
                transpose_item(args.in[2], NIN, Win_t, DM, dst - n0, 0, nullptr, scr, r, lane); continue; } r -= I_IN;
            if (r < I_ATT) { transpose_item(args.in[3], DM, Wcat_t, DM, 0, 0, nullptr, scr, r, lane); continue; } r -= I_ATT;
            if (r < I_GRP) {
#pragma unroll 1
                for (int rr = 0; rr < 8; ++rr) { const int row = r * 8 + rr, gg = row / 192;
#pragma unroll
                    for (int j = 0; j < 3; ++j) { const int col = j * 256 + lane * 4; u32x2 o = {0u, 0u};
                        if (col / 192 == gg) { const f32x4 wv = *(const f32x4*)(args.in[4] + (size_t)row * 192 + (col - 192 * gg)); o.x = pk2(wv.x, wv.y); o.y = pk2(wv.z, wv.w); }
                        *(u32x2*)(Wgrp_t + (size_t)row * PW + col) = o; } }
                continue; } r -= I_GRP;
            if (r < I_PO) { transpose_item(args.in[6], DM, WpoS_t, PW, 0, 0, args.in[5], scr, r, lane); continue; } r -= I_PO;
            if (r < I_OUT) { transpose_item(args.in[7], DM, Wout_t, DM, 0, 0, nullptr, scr, r, lane); continue; } r -= I_OUT;
            if (r < I_1) { transpose_item(args.in[9], FF, W1_t, DM, 0, 0, args.in[8], scr, r, lane); continue; } r -= I_1;
            if (r < I_2) { transpose_item(args.in[10], DM, W2_t, FF, 0, 0, nullptr, scr, r, lane); continue; } r -= I_2;
        }
        const float* g1 = args.in[1];
        for (int m = gw; m < S; m += 2 * NGW) {
            const int m2 = m + NGW; const bool has2 = m2 < S;
            const f32x4* xr = (const f32x4*)(x + (size_t)m * DM) + lane;
            const f32x4* xr2 = (const f32x4*)(x + (size_t)(has2 ? m2 : m) * DM) + lane;
            f32x4 v[4], v2[4]; float s = 0.f, s2 = 0.f;
#pragma unroll
            for (int j = 0; j < 4; ++j) { v[j] = __builtin_nontemporal_load(&xr[64 * j]); v2[j] = __builtin_nontemporal_load(&xr2[64 * j]); }
#pragma unroll
            for (int j = 0; j < 4; ++j) { s += (v[j].x * v[j].x + v[j].y * v[j].y) + (v[j].z * v[j].z + v[j].w * v[j].w); s2 += (v2[j].x * v2[j].x + v2[j].y * v2[j].y) + (v2[j].z * v2[j].z + v2[j].w * v2[j].w); }
            const float rstd = 1.0f / sqrtf(wave_sum(s) * (1.0f / DM) + EPS), rstd2 = 1.0f / sqrtf(wave_sum(s2) * (1.0f / DM) + EPS);
            unsigned long long* o8 = (unsigned long long*)(Ub + (size_t)m * DM) + lane;
            unsigned long long* o82 = (unsigned long long*)(Ub + (size_t)(has2 ? m2 : m) * DM) + lane;
#pragma unroll
            for (int j = 0; j < 4; ++j) { const f32x4 gv = *((const f32x4*)g1 + lane + 64 * j);
                o8[64 * j] = (unsigned long long)pk2(v[j].x * rstd * gv.x, v[j].y * rstd * gv.y) | ((unsigned long long)pk2(v[j].z * rstd * gv.z, v[j].w * rstd * gv.w) << 32);
                if (has2) o82[64 * j] = (unsigned long long)pk2(v2[j].x * rstd2 * gv.x, v2[j].y * rstd2 * gv.y) | ((unsigned long long)pk2(v2[j].z * rstd2 * gv.z, v2[j].w * rstd2 * gv.w) << 32); }
        }
        for (int i = bx * (NWAVES * 64) + tid; i < S; i += G * NWAVES * 64) { ssq[i] = 0.f; ssq2[i] = 0.f; }
        REP_END(0);
    }
    SEAM(0);

    if (IN(1)) REP(1) {
        pg8::Gemm g{Ub, Win_t}; pg8::StaticOrder So; So.init(S, NIN, G, bx);
        pg8::EpiZ E{Zb};
        pg8::gemm_phase<pg8::EpiZ, pg8::StaticOrder, DM, DM, 0, true>(lds, g, So, E, wave_s);
        REP_END(1);
    }
    SEAM(1);

    if (IN(2)) REP(2) {
        FRESH_IDS
        if ((G & 7) == 0) {
            const int x8 = bx & 7, r8 = bx >> 3, per = G >> 3;
            u32x4 kg[2][4], vg[2][4];
            const int w0 = x8 * 96 + r8, we = x8 * 96 + 96;
            if (w0 < we) attn_stage_load(Zb, w0, wave, lane, kg, vg);
            for (int wu = w0; wu < we; wu += per) attn_wg_unit(Zb, OG, LSE, wu, (wu + per < we) ? wu + per : -1, kg, vg, lds, wave, lane);
        } else {
            u32x4 kg[2][4], vg[2][4];
            if (bx < 768) attn_stage_load(Zb, bx, wave, lane, kg, vg);
            for (int wu = bx; wu < 768; wu += G) attn_wg_unit(Zb, OG, LSE, wu, (wu + G < 768) ? wu + G : -1, kg, vg, lds, wave, lane);
        }
        if ((G & 7) == 0) {
            const int x8 = bx & 7, r8 = bx >> 3, per = (G >> 3) * NWAVES;
            for (int pw = x8 * 768 + r8 * NWAVES + wave; pw < x8 * 768 + 768; pw += per) pool_wave_unit(Zb, APb, pw, lane);
        } else
        for (int pw = gw; pw < 6144; pw += NGW) pool_wave_unit(Zb, APb, pw, lane);
        REP_END(2);
    }
    SEAM(2);

    if (IN(3)) REP(3) {
        FRESH_IDS
        const int mg0 = G > 24 ? 12 : 0;
        for (int e = (bx - mg0) * (NWAVES * 64) + tid; bx >= mg0 && e < S * 32; e += (G - mg0) * NWAVES * 64) {
            const int t = e >> 5, sc = e & 31, slot = sc >> 3;
            const float l0 = LSE[((size_t)0 * S + t) * 4 + slot], l1 = LSE[((size_t)1 * S + t) * 4 + slot], l2 = LSE[((size_t)2 * S + t) * 4 + slot];
            const float mx = fmaxf(l0, fmaxf(l1, l2));
            float w0 = __builtin_amdgcn_exp2f(l0 - mx), w1 = __builtin_amdgcn_exp2f(l1 - mx), w2 = __builtin_amdgcn_exp2f(l2 - mx);
            const float inv = 1.0f / (w0 + w1 + w2); w0 *= inv; w1 *= inv; w2 *= inv;
            const u32x4 a0 = *(const u32x4*)(OG + ((size_t)0 * S + t) * AM + sc * 8), a1 = *(const u32x4*)(OG + ((size_t)1 * S + t) * AM + sc * 8), a2 = *(const u32x4*)(OG + ((size_t)2 * S + t) * AM + sc * 8);
            u32x4 o;
#pragma unroll
            for (int q = 0; q < 4; ++q) o[q] = cvtpk(w0 * bflo(a0[q]) + w1 * bflo(a1[q]) + w2 * bflo(a2[q]), w0 * bfhi(a0[q]) + w1 * bfhi(a1[q]) + w2 * bfhi(a2[q]));
            *(u32x4*)(APb + (size_t)t * DM + sc * 8) = o;
        }
        pg8::Gemm g{WpoS_t, Wgrp_t}; pg8::StaticOrder So; So.init(DM, PW, G, bx);
        pg8::EpiWcomb E{Wcat_t};
        pg8::gemm_phase<pg8::EpiWcomb, pg8::StaticOrder, PW, 384, 192, true>(lds, g, So, E, wave_s);
        REP_END(3);
    }
    SEAM(3);

    if (IN(4)) REP(4) {
        pg8::Gemm g{APb, Wcat_t}; pg8::StaticOrder So; So.init(S, DM, G, bx);
        pg8::EpiMerged E{Zb, MG};
        pg8::gemm_phase<pg8::EpiMerged, pg8::StaticOrder, DM, DM, 0, true>(lds, g, So, E, wave_s);
        REP_END(4);
    }
    SEAM(4);

    if (IN(5)) {
        pg8::Gemm g{MG, Wout_t}; pg8::StaticOrder So; So.init(S, DM, G, bx);
        pg8::EpiWout E{x, HB, ssq, (LAS float*)(lds + pg8::STAGE_BYTES)};
        pg8::gemm_phase<pg8::EpiWout, pg8::StaticOrder, DM, DM, 0, true>(lds, g, So, E, wave_s);
    }
    SEAM(5);

    if (IN(6)) REP(6) {
        pg8::Gemm g{HB, W1_t}; pg8::StaticOrder So; So.init(S, FF, G, bx);
        pg8::EpiUp E{HID, ssq};
        pg8::gemm_phase<pg8::EpiUp, pg8::StaticOrder, DM, DM, 0, true>(lds, g, So, E, wave_s);
        REP_END(6);
    }
    SEAM(6);

    if (IN(7)) {
        pg8::Gemm g{HID, W2_t}; pg8::StaticOrder So; So.init(S, DM, G, bx);
        pg8::EpiDownNorm E{HB, out, ssq2, (unsigned*)(ws + WS_CNT), args.in[11], (LAS float*)(lds + pg8::STAGE_BYTES)};
        pg8::gemm_phase<pg8::EpiDownNorm, pg8::StaticOrder, FF, FF, 0, true>(lds, g, So, E, wave_s);
    }
#undef IN
#undef SEAM
}

#ifndef MK_PER_PHASE
#define MK_PER_PHASE 0
#endif
extern "C" void kernel_launch(void* const* d_in, const int* in_sizes, int n_in, void* d_out, int out_size, void* d_ws, size_t ws_size, hipStream_t stream) {
    static int grid = 0;
    if (grid == 0) {
        if (n_in != 12 || out_size != S * DM || ws_size < WS_END) { fprintf(stderr, "kernel_launch: unexpected shapes (n_in %d out %d ws %zu)\n", n_in, out_size, ws_size); grid = -1; return; }
        int dev = 0, cus = 0, per_cu = 0;
        hipGetDevice(&dev);
        hipDeviceGetAttribute(&cus, hipDeviceAttributeMultiprocessorCount, dev);
        if (hipFuncSetAttribute((const void*)fwd_megakernel, hipFuncAttributeMaxDynamicSharedMemorySize, LDS_BYTES) != hipSuccess) { fprintf(stderr, "kernel_launch: hipFuncSetAttribute failed\n"); grid = -1; return; }
        if (hipOccupancyMaxActiveBlocksPerMultiprocessor(&per_cu, (const void*)fwd_megakernel, NWAVES * 64, LDS_BYTES) != hipSuccess || per_cu < 1) { fprintf(stderr, "kernel_launch: occupancy query gave %d\n", per_cu); per_cu = 1; }
        (void)hipGetLastError();
        grid = cus * (per_cu > 1 ? 1 : per_cu);
        fprintf(stderr, "kernel_launch: grid %d (cus %d, per_cu %d)\n", grid, cus, per_cu);
    }
    if (grid < 0) return;
    Args a{};
    for (int i = 0; i < 12; ++i) a.in[i] = (const float*)d_in[i];
    a.out = (float*)d_out; a.ws = (unsigned char*)d_ws;
#if MK_PER_PHASE
    for (int p = 0; p < NPHASE; ++p) { a.ph_lo = p; a.ph_hi = p + 1; hipLaunchKernelGGL(fwd_megakernel, dim3(grid), dim3(NWAVES * 64), LDS_BYTES, stream, a); }
#else
    a.ph_lo = 0; a.ph_hi = NPHASE;
    if (hipMemsetAsync((char*)d_ws + WS_BAR, 0, BAR_BYTES, stream) != hipSuccess) { fprintf(stderr, "kernel_launch: memset failed\n"); return; }
    void* kargs[] = {&a};
    hipError_t e = hipLaunchCooperativeKernel((void*)fwd_megakernel, dim3(grid), dim3(NWAVES * 64), kargs, LDS_BYTES, stream);
    if (e != hipSuccess) fprintf(stderr, "kernel_launch: cooperative launch failed: %s (grid %d)\n", hipGetErrorString(e), grid);
#endif
}
```
